# Optimizing an MI355X kernel written in HIP

```python
import math
import jax, jax.numpy as jnp
from jax import lax
import numpy as np

D_MODEL = 1024
BATCH = 8
SEQ = 2048
DEPTH = 1
DEC_BATCH = 128
DEC_SEQ = 1
PAST_LEN = 16384
PAGE_SIZE = 128

LRU_WIDTH = 768
N_LRU_BLOCKS = 6
LRU_BLOCK = LRU_WIDTH // N_LRU_BLOCKS
LRU_CONV = 4
LRU_C = 8.0
SC_WIDTH = 768
SC_GROUPS = 6
SC_CONV = 3
N_MEM = 256
XA_HEADS = 4
XA_HEAD_DIM = 128
XA_WIDTH = XA_HEADS * XA_HEAD_DIM
N_BRANCH = 3
EPS = 1e-6

IN_COLS = 2 * LRU_WIDTH + 4 * SC_WIDTH + 2 * XA_WIDTH + N_BRANCH * D_MODEL
SPLIT_POINTS = (
    LRU_WIDTH,
    2 * LRU_WIDTH,
    2 * LRU_WIDTH + SC_WIDTH,
    2 * LRU_WIDTH + 2 * SC_WIDTH,
    2 * LRU_WIDTH + 3 * SC_WIDTH,
    2 * LRU_WIDTH + 4 * SC_WIDTH,
    2 * LRU_WIDTH + 4 * SC_WIDTH + XA_WIDTH,
    2 * LRU_WIDTH + 4 * SC_WIDTH + 2 * XA_WIDTH,
)

kernel_name = "hawk_shortconv_memxattn_step"


def rmsnorm(x, g):
    xf = x.astype(jnp.float32)
    ms = jnp.mean(xf * xf, axis=-1, keepdims=True)
    return (xf * lax.rsqrt(ms + EPS)).astype(x.dtype) * g


def causal_dwconv(x, buf, w):
    width = w.shape[0]
    t = x.shape[1]
    xp = jnp.concatenate([buf.astype(x.dtype), x], axis=1)
    y = xp[:, 0:t] * w[0]
    for k in range(1, width):
        y = y + xp[:, k:k + t] * w[k]
    return y, xp[:, t:]


def rglru(xc, h0, wa, ba, wx, bx, lam):
    bn, t, c = xc.shape
    xb = xc.reshape(bn, t, N_LRU_BLOCKS, LRU_BLOCK)
    r = jax.nn.sigmoid(jnp.einsum('btnc,ncd->btnd', xb, wa).reshape(bn, t, c) + ba)
    i = jax.nn.sigmoid(jnp.einsum('btnc,ncd->btnd', xb, wx).reshape(bn, t, c) + bx)
    log_a = -LRU_C * r.astype(jnp.float32) * jax.nn.softplus(-lam.astype(jnp.float32))
    a = jnp.exp(log_a)
    mult = jnp.sqrt(jnp.maximum(-jnp.expm1(2.0 * log_a), 0.0))
    b_in = mult * (i * xc).astype(jnp.float32)

    def step(h, inp):
        a_t, b_t = inp
        h = a_t * h + b_t
        return h, h

    h_last, hs = lax.scan(step, h0.astype(jnp.float32),
                          (jnp.swapaxes(a, 0, 1), jnp.swapaxes(b_in, 0, 1)))
    return jnp.swapaxes(hs, 0, 1).astype(xc.dtype), h_last.astype(h0.dtype)


def memory_kv(mem, mem_norm_g, xa_wk, xa_wv):
    m = rmsnorm(mem, mem_norm_g)
    bn = mem.shape[0]
    k = (m @ xa_wk).reshape(bn, N_MEM, XA_HEADS, XA_HEAD_DIM)
    v = (m @ xa_wv).reshape(bn, N_MEM, XA_HEADS, XA_HEAD_DIM)
    return k, v


def hybrid_layer(x, mem_k, mem_v, lru_h, lru_buf, sc_buf,
                 norm_g, w_in, lru_conv_w, lru_conv_b, lru_wa, lru_ba, lru_wx, lru_bx,
                 lru_lambda, lru_wo, sconv_w, sconv_wo, xa_wo, w_out):
    bn, t, _ = x.shape
    u = rmsnorm(x, norm_g)
    proj = u @ w_in
    lx, lg, sb, scg, sh, sg, q, qg, mg = jnp.split(proj, SPLIT_POINTS, axis=-1)

    xc, new_lru_buf = causal_dwconv(lx, lru_buf, lru_conv_w)
    xc = xc + lru_conv_b
    hs, new_h = rglru(xc, lru_h, lru_wa, lru_ba, lru_wx, lru_bx, lru_lambda)
    z_a = (hs * jax.nn.silu(lg)) @ lru_wo

    cin = scg * sh
    cy, new_sc_buf = causal_dwconv(cin, sc_buf, sconv_w)
    z_b = (jax.nn.silu(sg) * sb * cy) @ sconv_wo

    qh = q.reshape(bn, t, XA_HEADS, XA_HEAD_DIM)
    s = jnp.einsum('bthd,bmhd->bhtm', qh, mem_k.astype(qh.dtype)).astype(jnp.float32)
    p = jax.nn.softmax(s * (1.0 / math.sqrt(XA_HEAD_DIM)), axis=-1).astype(x.dtype)
    o = jnp.einsum('bhtm,bmhd->bthd', p, mem_v.astype(x.dtype)).reshape(bn, t, XA_WIDTH)
    z_c = (o * jax.nn.silu(qg)) @ xa_wo

    g = jax.nn.sigmoid(mg)
    g_a, g_b, g_c = jnp.split(g, N_BRANCH, axis=-1)
    y = (g_a * z_a + g_b * z_b + g_c * z_c) @ w_out
    return x + y, new_h, new_lru_buf, new_sc_buf


def setup_inputs(seed: int = 0) -> dict:
    key = jax.random.key(seed)
    ks = jax.random.split(key, 32)
    f32 = jnp.float32
    nrm = lambda k, shape, s: (jax.random.normal(k, shape, f32) * s)

    x_prompt = nrm(ks[0], (BATCH, SEQ, D_MODEL), 1.0)
    x_sample = nrm(ks[1], (DEC_BATCH, DEC_SEQ, D_MODEL), 1.0)
    cache_mem_k = nrm(ks[2], (DEPTH, DEC_BATCH, N_MEM, XA_HEADS, XA_HEAD_DIM), 1.0)
    cache_mem_v = nrm(ks[3], (DEPTH, DEC_BATCH, N_MEM, XA_HEADS, XA_HEAD_DIM), 1.0)
    state_lru_h = nrm(ks[4], (DEPTH, DEC_BATCH, LRU_WIDTH), 0.5)
    state_lru_conv = nrm(ks[5], (DEPTH, DEC_BATCH, LRU_CONV - 1, LRU_WIDTH), 1.0)
    state_sconv = nrm(ks[6], (DEPTH, DEC_BATCH, SC_CONV - 1, SC_WIDTH), 1.0)
    mem_prompt = nrm(ks[7], (BATCH, N_MEM, D_MODEL), 1.0)

    norm_g = 1.0 + nrm(ks[8], (DEPTH, D_MODEL), 0.02)
    mem_norm_g = 1.0 + nrm(ks[9], (DEPTH, D_MODEL), 0.02)
    w_in = nrm(ks[10], (DEPTH, D_MODEL, IN_COLS), D_MODEL ** -0.5)
    lru_conv_w = nrm(ks[11], (DEPTH, LRU_CONV, LRU_WIDTH), LRU_CONV ** -0.5)
    lru_conv_b = nrm(ks[12], (DEPTH, LRU_WIDTH), 0.01)
    lru_wa = nrm(ks[13], (DEPTH, N_LRU_BLOCKS, LRU_BLOCK, LRU_BLOCK), LRU_BLOCK ** -0.5)
    lru_ba = nrm(ks[14], (DEPTH, LRU_WIDTH), 0.01)
    lru_wx = nrm(ks[15], (DEPTH, N_LRU_BLOCKS, LRU_BLOCK, LRU_BLOCK), LRU_BLOCK ** -0.5)
    lru_bx = nrm(ks[16], (DEPTH, LRU_WIDTH), 0.01)
    a_c = jax.random.uniform(ks[17], (DEPTH, LRU_WIDTH), f32, 0.9, 0.999)
    a0 = a_c ** (1.0 / LRU_C)
    lru_lambda = jnp.log(a0) - jnp.log1p(-a0)
    lru_wo = nrm(ks[18], (DEPTH, LRU_WIDTH, D_MODEL), LRU_WIDTH ** -0.5)
    sconv_w = nrm(ks[19], (DEPTH, SC_CONV, SC_WIDTH), SC_CONV ** -0.5)
    sconv_wo = nrm(ks[20], (DEPTH, SC_WIDTH, D_MODEL), SC_WIDTH ** -0.5)
    xa_wk = nrm(ks[21], (DEPTH, D_MODEL, XA_WIDTH), D_MODEL ** -0.5)
    xa_wv = nrm(ks[22], (DEPTH, D_MODEL, XA_WIDTH), D_MODEL ** -0.5)
    xa_wo = nrm(ks[23], (DEPTH, XA_WIDTH, D_MODEL), XA_WIDTH ** -0.5)
    w_out = nrm(ks[24], (DEPTH, D_MODEL, D_MODEL), D_MODEL ** -0.5)
    final_norm_g = 1.0 + nrm(ks[25], (D_MODEL,), 0.02)

    return {
        "x_prompt": x_prompt, "x_sample": x_sample,
        "cache_mem_k": cache_mem_k, "cache_mem_v": cache_mem_v,
        "state_lru_h": state_lru_h, "state_lru_conv": state_lru_conv,
        "state_sconv": state_sconv, "mem_prompt": mem_prompt,
        "norm_g": norm_g, "mem_norm_g": mem_norm_g, "w_in": w_in,
        "lru_conv_w": lru_conv_w, "lru_conv_b": lru_conv_b,
        "lru_wa": lru_wa, "lru_ba": lru_ba, "lru_wx": lru_wx, "lru_bx": lru_bx,
        "lru_lambda": lru_lambda, "lru_wo": lru_wo,
        "sconv_w": sconv_w, "sconv_wo": sconv_wo,
        "xa_wk": xa_wk, "xa_wv": xa_wv, "xa_wo": xa_wo,
        "w_out": w_out, "final_norm_g": final_norm_g,
    }


def reference(x_prompt, x_sample, cache_mem_k, cache_mem_v, state_lru_h, state_lru_conv,
              state_sconv, mem_prompt, norm_g, mem_norm_g, w_in, lru_conv_w, lru_conv_b,
              lru_wa, lru_ba, lru_wx, lru_bx, lru_lambda, lru_wo, sconv_w, sconv_wo,
              xa_wk, xa_wv, xa_wo, w_out, final_norm_g):
    xp = x_prompt
    xs = x_sample
    bp = x_prompt.shape[0]
    p_mk, p_mv, p_h, p_lb, p_sb = [], [], [], [], []
    s_h, s_lb, s_sb = [], [], []
    for l in range(DEPTH):
        lw = (norm_g[l], w_in[l], lru_conv_w[l], lru_conv_b[l], lru_wa[l], lru_ba[l],
              lru_wx[l], lru_bx[l], lru_lambda[l], lru_wo[l], sconv_w[l], sconv_wo[l],
              xa_wo[l], w_out[l])
        mk, mv = memory_kv(mem_prompt, mem_norm_g[l], xa_wk[l], xa_wv[l])
        h0 = jnp.zeros((bp, LRU_WIDTH), xp.dtype)
        lb0 = jnp.zeros((bp, LRU_CONV - 1, LRU_WIDTH), xp.dtype)
        sb0 = jnp.zeros((bp, SC_CONV - 1, SC_WIDTH), xp.dtype)
        xp, ph, plb, psb = hybrid_layer(xp, mk, mv, h0, lb0, sb0, *lw)
        p_mk.append(mk); p_mv.append(mv); p_h.append(ph); p_lb.append(plb); p_sb.append(psb)
        xs, sh, slb, ssb = hybrid_layer(xs, cache_mem_k[l], cache_mem_v[l], state_lru_h[l],
                                        state_lru_conv[l], state_sconv[l], *lw)
        s_h.append(sh); s_lb.append(slb); s_sb.append(ssb)
    y_prompt = rmsnorm(xp, final_norm_g)
    y_sample = rmsnorm(xs, final_norm_g)
    return (y_prompt, y_sample,
            jnp.stack(p_mk), jnp.stack(p_mv), jnp.stack(p_h), jnp.stack(p_lb), jnp.stack(p_sb),
            jnp.stack(s_h), jnp.stack(s_lb), jnp.stack(s_sb))
```

```cpp
#include <hip/hip_runtime.h>
#include <cstdio>
#include <cstdint>

#define LAS __attribute__((address_space(3)))
typedef unsigned short bf16_t;
typedef short bf16x8 __attribute__((ext_vector_type(8)));
typedef float f32x4 __attribute__((ext_vector_type(4)));
typedef float f32x16 __attribute__((ext_vector_type(16)));
typedef unsigned u32x4 __attribute__((ext_vector_type(4)));
typedef unsigned u32x2 __attribute__((ext_vector_type(2)));

constexpr int D = 1024, NB = 8, SEQ = 2048, MP = NB * SEQ, NS = 128, MT = MP + NS, MPAD = 16640;
constexpr int NMEM = 256, MEMROWS = NB * NMEM, UROWS = MPAD + MEMROWS;
constexpr int LW = 768, NLB = 6, LBW = 128, XH = 4, XD = 128, XW = 512, INC = 8704;
constexpr float EPS = 1e-6f;
constexpr int PC_GA = 0, PC_GB = 768, PC_GC = 1536, PC_LX = 2048, PC_CIN = 2816, PC_Q = 3584, PC_G = 4096, PLD = 7168, PC_MRG = 2048;
constexpr int TC = 64, NCH = SEQ / TC;
constexpr size_t O_Y = 0, O_PMK = (size_t)MT * D, O_PMV = O_PMK + (size_t)MEMROWS * XW, O_PH = O_PMV + (size_t)MEMROWS * XW,
                 O_PLC = O_PH + NB * LW, O_PSC = O_PLC + NB * 3 * LW, O_SH = O_PSC + NB * 2 * LW, O_SLC = O_SH + NS * LW, O_SSC = O_SLC + NS * 3 * LW,
                 O_END = O_SSC + NS * 2 * LW;
constexpr size_t MiB = 1u << 20;
constexpr size_t WS_P = 0, WS_WCAT = 228 * MiB, WS_WOUT = 232 * MiB, WS_WG = 234 * MiB, WS_KB = 235 * MiB, WS_VT = 237 * MiB, WS_AGG = 239 * MiB,
                 WS_RSS = 241 * MiB, WS_CTL = 244 * MiB, WS_END = 245 * MiB;
static_assert((size_t)MPAD * PLD * 2 <= WS_WCAT, "P fits");
constexpr size_t DO_U = 0, DO_WIN = 40 * MiB;
static_assert((size_t)UROWS * D * 2 <= DO_WIN && DO_WIN + (size_t)9728 * D * 2 <= (size_t)MP * D * 4, "d_out scratch fits under y_prompt");
constexpr int LDS_BYTES = 147456;

typedef float f32x2_t __attribute__((ext_vector_type(2))); typedef __bf16 bf16x2_t __attribute__((ext_vector_type(2)));
__device__ __forceinline__ unsigned cvt_pk_bf16(float lo, float hi) { const f32x2_t v = {lo, hi}; const bf16x2_t b = __builtin_convertvector(v, bf16x2_t); return __builtin_bit_cast(unsigned, b); }
__device__ __forceinline__ float bflo(unsigned w) { return __uint_as_float(w << 16); }
__device__ __forceinline__ float bfhi(unsigned w) { return __uint_as_float(w & 0xffff0000u); }
__device__ __forceinline__ float bf2f(bf16_t v) { return __uint_as_float(((unsigned)v) << 16); }
__device__ __forceinline__ float sigm(float x) { return __builtin_amdgcn_rcpf(1.f + __expf(-x)); }
__device__ __forceinline__ float silu(float x) { return x * sigm(x); }
__device__ __forceinline__ float wave_sum(float v) {
#pragma unroll
    for (int o = 1; o < 64; o <<= 1) v += __shfl_xor(v, o);
    return v;
}
__device__ __forceinline__ float wave_max(float v) {
#pragma unroll
    for (int o = 1; o < 64; o <<= 1) v = fmaxf(v, __shfl_xor(v, o));
    return v;
}
__device__ __forceinline__ void unpack8(const u32x4 w, float* f) {
    f[0] = bflo(w.x); f[1] = bfhi(w.x); f[2] = bflo(w.y); f[3] = bfhi(w.y); f[4] = bflo(w.z); f[5] = bfhi(w.z); f[6] = bflo(w.w); f[7] = bfhi(w.w);
}
__device__ __forceinline__ u32x4 pack8(const float* f) {
    u32x4 w; w.x = cvt_pk_bf16(f[0], f[1]); w.y = cvt_pk_bf16(f[2], f[3]); w.z = cvt_pk_bf16(f[4], f[5]); w.w = cvt_pk_bf16(f[6], f[7]); return w;
}

namespace pg8 {
constexpr int BM = 256, BK = 64, HALF = 128, HTB = HALF * BK * 2, STAGE_BYTES = 8 * HTB, NXCD = 8, WGM = 8;
__host__ __device__ __forceinline__ int lds_byte(int r, int c) { const int st = (r >> 4) * 2 + (c >> 5), rr = r & 15, cc = c & 31, ob = rr * 64 + cc * 2; return st * 1024 + (ob ^ (((ob >> 9) & 1) << 5)); }
__host__ __device__ __forceinline__ void stage_rc(int b, int& R, int& C) { const int st = b / 1024, sb = b % 1024, swz = sb ^ (((sb >> 9) & 1) << 5); R = (st >> 1) * 16 + swz / 64; C = (st & 1) * 32 + (swz % 64) / 2; }
__host__ __device__ __forceinline__ int perm32(int rho) { const int n = rho >> 4, i = rho & 15; return 8 * (i >> 2) + 4 * n + (i & 3); }

struct Unit { int pm, pn, seg; };
struct Gemm { const bf16_t* A; const bf16_t* Bt; int lda, ldb; };

template <class Epi, class Sched>
__device__ __forceinline__ void gemm_phase(LAS unsigned char* lds, const Gemm g, const Sched& S, const Epi& E) {
    const int tid = threadIdx.x, wid = __builtin_amdgcn_readfirstlane(tid >> 6), lane = tid & 63, wr = wid >> 2, wc = wid & 3, fr = lane & 15, fq = lane >> 4;
    unsigned voffA[2], voffB[2];
#pragma unroll
    for (int i = 0; i < 2; ++i) { int R, C; stage_rc(tid * 16 + i * 8192, R, C); const int Rb = Epi::PERM ? ((R & ~31) + perm32(R & 31)) : R;
        voffA[i] = (unsigned)(R * g.lda + C) * 2u; voffB[i] = (unsigned)(Rb * g.ldb + C) * 2u; }
    const size_t kstep = (size_t)(BK * 2);
    const size_t hstepA = (size_t)HALF * g.lda * 2, hstepB = (size_t)HALF * g.ldb * 2;
    const unsigned ldsw = (unsigned)wid * 1024u;
    const int aoff = lds_byte(wr * 64 + fr, fq * 8), boff = lds_byte(wc * 32 + fr, fq * 8);
#define PG8_SA(b, h) (((b) * 2 + (h)) * HTB)
#define PG8_SB(b, h) ((4 + (b) * 2 + (h)) * HTB)
#define PG8_STAGE(bufoff, gbase, voff) do { _Pragma("unroll") for (int _i = 0; _i < 2; ++_i) \
        __builtin_amdgcn_global_load_lds((const unsigned*)((const char*)(gbase) + (voff)[_i]), (LAS unsigned*)(lds + (bufoff) + ldsw + _i * 8192), 16, 0, 0); } while (0)
#define PG8_LDA(dst, b, h) do { _Pragma("unroll") for (int m = 0; m < 4; ++m) _Pragma("unroll") for (int k = 0; k < 2; ++k) dst[m][k] = *(const LAS bf16x8*)(lds + PG8_SA(b, h) + aoff + m * 2048 + k * 1024); } while (0)
#define PG8_LDB(dst, b, h) do { _Pragma("unroll") for (int n = 0; n < 2; ++n) _Pragma("unroll") for (int k = 0; k < 2; ++k) dst[n][k] = *(const LAS bf16x8*)(lds + PG8_SB(b, h) + boff + n * 2048 + k * 1024); } while (0)
#define PG8_MMA(ai, bj, At, Bt) do { __builtin_amdgcn_s_setprio(1); _Pragma("unroll") for (int m = 0; m < 4; ++m) _Pragma("unroll") for (int n = 0; n < 2; ++n) _Pragma("unroll") for (int k = 0; k < 2; ++k) \
        acc[ai][bj][m][n] = __builtin_amdgcn_mfma_f32_16x16x32_bf16(Bt[n][k], At[m][k], acc[ai][bj][m][n], 0, 0, 0); __builtin_amdgcn_s_setprio(0); } while (0)
#define PG8_WAIT_V(n) asm volatile("s_waitcnt vmcnt(" #n ")" ::: "memory")
#define PG8_WAIT_L(n) asm volatile("s_waitcnt lgkmcnt(" #n ")" ::: "memory")
#define PG8_BAR __builtin_amdgcn_s_barrier()
#define PG8_SCHED __builtin_amdgcn_sched_barrier(0)
    Unit cur, nxt; int ui = 0;
    if (!S.next(0, cur)) return;
    f32x4 acc[2][2][4][2];
#pragma unroll
    for (int a = 0; a < 2; ++a)
#pragma unroll
        for (int b = 0; b < 2; ++b)
#pragma unroll
            for (int m = 0; m < 4; ++m)
#pragma unroll
                for (int n = 0; n < 2; ++n) acc[a][b][m][n] = (f32x4){0.f, 0.f, 0.f, 0.f};
    bf16x8 At[4][2], B0[2][2], B1[2][2];
    const char* cA = (const char*)g.A + S.a_off(cur); const char* cB = (const char*)g.Bt + S.b_off(cur);
    int nt = S.nt(cur);
    PG8_STAGE(PG8_SB(0, 0), cB, voffB); PG8_STAGE(PG8_SB(0, 1), cB + hstepB, voffB); PG8_STAGE(PG8_SA(0, 0), cA, voffA); PG8_STAGE(PG8_SA(0, 1), cA + hstepA, voffA);
    if (wr == 1) PG8_BAR;
    PG8_WAIT_V(2); PG8_BAR;
    PG8_STAGE(PG8_SB(1, 0), cB + kstep, voffB); PG8_STAGE(PG8_SA(1, 0), cA + kstep, voffA); PG8_STAGE(PG8_SB(1, 1), cB + hstepB + kstep, voffB);
    PG8_WAIT_V(6); PG8_BAR;
    for (;;) {
        const bool has_next = S.next(ui + 1, nxt);
        const char* nA = has_next ? (const char*)g.A + S.a_off(nxt) : cA; const char* nB = has_next ? (const char*)g.Bt + S.b_off(nxt) : cB;
        for (int t = 0; t < nt; t += 2) {
            const bool last = (t == nt - 2);
            const char* a1 = cA + (size_t)(t + 1) * kstep;
            const char* a2 = last ? nA : cA + (size_t)(t + 2) * kstep; const char* b2 = last ? nB : cB + (size_t)(t + 2) * kstep;
            const char* a3 = a2 + kstep; const char* b3 = b2 + kstep;
            PG8_LDB(B0, 0, 0); PG8_LDB(B1, 0, 1); PG8_SCHED; PG8_LDA(At, 0, 0); PG8_STAGE(PG8_SA(1, 1), a1 + hstepA, voffA);
            PG8_WAIT_V(8); PG8_WAIT_L(0); PG8_BAR; PG8_MMA(0, 0, At, B0); PG8_MMA(0, 1, At, B1); PG8_BAR; PG8_SCHED;
            PG8_LDA(At, 0, 1); PG8_STAGE(PG8_SB(0, 0), b2, voffB); PG8_STAGE(PG8_SB(0, 1), b2 + hstepB, voffB); PG8_STAGE(PG8_SA(0, 0), a2, voffA);
            PG8_WAIT_V(8); PG8_WAIT_L(0); PG8_BAR; PG8_MMA(1, 0, At, B0); PG8_MMA(1, 1, At, B1); PG8_BAR; PG8_SCHED;
            PG8_LDB(B0, 1, 0); PG8_LDB(B1, 1, 1); PG8_SCHED; PG8_LDA(At, 1, 0); PG8_STAGE(PG8_SA(0, 1), a2 + hstepA, voffA);
            PG8_WAIT_V(8); PG8_WAIT_L(0); PG8_BAR; PG8_MMA(0, 0, At, B0); PG8_MMA(0, 1, At, B1); PG8_BAR; PG8_SCHED;
            PG8_LDA(At, 1, 1); PG8_STAGE(PG8_SB(1, 0), b3, voffB); PG8_STAGE(PG8_SB(1, 1), b3 + hstepB, voffB); PG8_STAGE(PG8_SA(1, 0), a3, voffA);
            PG8_WAIT_V(8); PG8_WAIT_L(0); PG8_BAR; PG8_MMA(1, 0, At, B0); PG8_MMA(1, 1, At, B1); PG8_BAR; PG8_SCHED;
        }
        if (wr == 0) PG8_BAR;
        const bool keep = E(acc, cur, wr, wc, fr, fq);
        if (!has_next) break;
        if (!keep) {
#pragma unroll
            for (int a = 0; a < 2; ++a)
#pragma unroll
                for (int b = 0; b < 2; ++b)
#pragma unroll
                    for (int m = 0; m < 4; ++m)
#pragma unroll
                        for (int n = 0; n < 2; ++n) acc[a][b][m][n] = (f32x4){0.f, 0.f, 0.f, 0.f};
        }
        cur = nxt; cA = nA; cB = nB; nt = S.nt(cur); ++ui;
        if (wr == 1) PG8_BAR;
    }
    PG8_WAIT_V(0);
    PG8_BAR;
#undef PG8_SA
#undef PG8_SB
#undef PG8_STAGE
#undef PG8_LDA
#undef PG8_LDB
#undef PG8_MMA
#undef PG8_WAIT_V
#undef PG8_WAIT_L
#undef PG8_BAR
#undef PG8_SCHED
}
}
using pg8::Unit;

#define XB_TMO      128
#define XB_XCNT(j)  (256  + 64 * (j))
#define XB_XSUB(j)  (1280 + 64 * (j))
#define XB_XGEN(j)  (2304 + 64 * (j))
#define XB_TOP      3328
#define XB_TOPGEN   3392
#define XCD_BAR_WORDS 3456
#define XB_SPIN_CAP (1u << 18)
__device__ __forceinline__ unsigned xb_ld(unsigned* p)              { return __hip_atomic_load(p, __ATOMIC_RELAXED, __HIP_MEMORY_SCOPE_AGENT); }
__device__ __forceinline__ unsigned xb_add(unsigned* p, unsigned v) { return __hip_atomic_fetch_add(p, v, __ATOMIC_RELAXED, __HIP_MEMORY_SCOPE_AGENT); }
__device__ __forceinline__ unsigned xb_xcc_id() { return (unsigned)__builtin_amdgcn_s_getreg((3 << 11) | 20) & 0xFu; }
#define XB_SPIN(cond, bar) do { unsigned _sp = 0; while (cond) { __builtin_amdgcn_s_sleep(1); \
    if ((++_sp & 255u) == 0u) { if (xb_ld(&(bar)[XB_TMO])) break; if (_sp > XB_SPIN_CAP) { atomicAdd(&(bar)[XB_TMO], 1u); break; } } } } while (0)
struct XcdBarrier { unsigned* bar; unsigned x; volatile LAS unsigned* st; };
__device__ __forceinline__ XcdBarrier xcd_barrier_post(unsigned* bar, volatile LAS unsigned* st) {
    XcdBarrier b; b.bar = bar; b.x = xb_xcc_id(); b.st = st;
    if (threadIdx.x == 0) (void)xb_add(&bar[XB_XCNT(b.x)], 1u);
    return b;
}
__device__ __forceinline__ void xcd_barrier_complete(unsigned* bar, unsigned x, unsigned& nloc, unsigned& nx) {
    const unsigned G = gridDim.x * gridDim.y * gridDim.z;
    unsigned sum, cnt, mine, sp = 0u;
    for (;;) {
        sum = 0u; cnt = 0u; mine = 0u;
#pragma unroll
        for (unsigned j = 0; j < 16; ++j) { const unsigned c = xb_ld(&bar[XB_XCNT(j)]); sum += c; cnt += (c > 0u) ? 1u : 0u; mine = (j == x) ? c : mine; }
        if (sum == G) break;
        __builtin_amdgcn_s_sleep(1);
        if ((++sp & 255u) == 0u) { if (xb_ld(&bar[XB_TMO])) break; if (sp > XB_SPIN_CAP) { atomicAdd(&bar[XB_TMO], 1u); break; } }
    }
    nloc = mine > 0u ? mine : 1u; nx = cnt > 0u ? cnt : 1u;
}
__device__ __forceinline__ void xcd_barrier(const XcdBarrier& b) {
    asm volatile("s_waitcnt vmcnt(0)" ::: "memory");
    __syncthreads();
    if (threadIdx.x == 0) {
        unsigned* bar = b.bar;
        __builtin_amdgcn_s_waitcnt(0);
        unsigned nloc = b.st[0], nx = b.st[1];
        if (nloc == 0u) { xcd_barrier_complete(bar, b.x, nloc, nx); b.st[0] = nloc; b.st[1] = nx; }
        const unsigned old = xb_add(&bar[XB_XSUB(b.x)], 1u);
        const unsigned gen = old / nloc;
        if (old + 1u == (gen + 1u) * nloc) {
            __builtin_amdgcn_fence(__ATOMIC_RELEASE, "agent");
            asm volatile("s_waitcnt vmcnt(0)" ::: "memory");
            const unsigned og = xb_add(&bar[XB_TOP], 1u);
            const unsigned tg = og / nx;
            if (og + 1u == (tg + 1u) * nx) xb_add(&bar[XB_TOPGEN], 1u);
            else XB_SPIN(xb_ld(&bar[XB_TOPGEN]) == tg, bar);
            __builtin_amdgcn_fence(__ATOMIC_ACQUIRE, "agent");
            xb_add(&bar[XB_XGEN(b.x)], 1u);
            asm volatile("s_waitcnt vmcnt(0)" ::: "memory");
        } else {
            XB_SPIN(xb_ld(&bar[XB_XGEN(b.x)]) == gen, bar);
            __builtin_amdgcn_fence(__ATOMIC_ACQUIRE, "agent");
            asm volatile("s_waitcnt vmcnt(0)" ::: "memory");
        }
    }
    __syncthreads();
}

struct Params { const float* in[26]; float* out; unsigned char* ws; int ph_lo, ph_hi; };
enum { I_XP = 0, I_XS, I_CK, I_CV, I_SH, I_SLC, I_SSC, I_MEM, I_NG, I_MNG, I_WIN, I_CW, I_CB, I_WA, I_BA, I_WX, I_BX, I_LAM, I_LWO, I_SCW, I_SWO, I_WK, I_WV, I_XWO, I_WOUT, I_FNG };

__device__ __forceinline__ int win_dst_row(int s) {
    if (s < 1536 || s >= 4608) { const int c = s & 255;
        return (s & ~255) + 128 * ((c >> 5) & 1) + 32 * (c >> 6) + (c & 31); }
    const int q = s - 1536, seg = q / 768, ch = q - seg * 768;
    return 1536 + 256 * (ch >> 6) + 128 * (seg >> 1) + 32 * ((ch & 63) >> 4) + 8 * ((ch & 15) >> 2) + 4 * (seg & 1) + (ch & 3);
}
template <int MAP>
__device__ __forceinline__ void transpose_item(const float* W, int ldw, int k0, int s0, bf16_t* WT, int ldo, int rowoff, int coloff, LAS float* scr, int lane) {
    { f32x4 v[8];
#pragma unroll
        for (int i = 0; i < 8; ++i) v[i] = __builtin_nontemporal_load((const f32x4*)(W + (size_t)(k0 + 8 * i + (lane >> 3)) * ldw + s0 + 4 * (lane & 7)));
#pragma unroll
        for (int i = 0; i < 8; ++i) { LAS float* d = scr + (8 * i + (lane >> 3)) * 33 + 4 * (lane & 7); d[0] = v[i][0]; d[1] = v[i][1]; d[2] = v[i][2]; d[3] = v[i][3]; } }
    asm volatile("s_waitcnt lgkmcnt(0)" ::: "memory");
    const int c = lane & 7;
#pragma unroll
    for (int j = 0; j < 4; ++j) { const int n = (lane >> 3) + 8 * j; const LAS float* s = scr + (8 * c) * 33 + n;
        u32x4 o; o.x = cvt_pk_bf16(s[0 * 33], s[1 * 33]); o.y = cvt_pk_bf16(s[2 * 33], s[3 * 33]); o.z = cvt_pk_bf16(s[4 * 33], s[5 * 33]); o.w = cvt_pk_bf16(s[6 * 33], s[7 * 33]);
        const int drow = MAP ? win_dst_row(s0 + n) : (rowoff + s0 + n);
        *(u32x4*)(WT + (size_t)drow * ldo + coloff + k0 + 8 * c) = o; }
    asm volatile("s_waitcnt lgkmcnt(0)" ::: "memory");
}
__device__ __forceinline__ void rms_row(const float* xrow, const float* g, bf16_t* orow, int lane) {
    const f32x4* xr = (const f32x4*)xrow + lane; const f32x4* gr = (const f32x4*)g + lane;
    f32x4 v[4]; float s = 0.f;
#pragma unroll
    for (int j = 0; j < 4; ++j) { v[j] = xr[64 * j]; s += (v[j].x * v[j].x + v[j].y * v[j].y) + (v[j].z * v[j].z + v[j].w * v[j].w); }
    const float rstd = 1.f / sqrtf(wave_sum(s) * (1.f / D) + EPS);
    u32x2* o8 = (u32x2*)orow + lane;
#pragma unroll
    for (int j = 0; j < 4; ++j) { const f32x4 gg = gr[64 * j]; u32x2 w; w.x = cvt_pk_bf16(v[j].x * rstd * gg.x, v[j].y * rstd * gg.y); w.y = cvt_pk_bf16(v[j].z * rstd * gg.z, v[j].w * rstd * gg.w); o8[64 * j] = w; }
}
__device__ __forceinline__ void p0_prologue(const Params& p, LAS unsigned char* lds, int gw, int NGW, int part) {
    const int tid = threadIdx.x, lane = tid & 63, wave = tid >> 6;
    LAS float* scr = (LAS float*)(lds + wave * 16384);
    bf16_t* WinT = (bf16_t*)((unsigned char*)p.out + DO_WIN); bf16_t* U = (bf16_t*)((unsigned char*)p.out + DO_U);
    bf16_t* WcatT = (bf16_t*)(p.ws + WS_WCAT); bf16_t* WoutT = (bf16_t*)(p.ws + WS_WOUT); bf16_t* WgT = (bf16_t*)(p.ws + WS_WG);
    constexpr int N0 = 16 * 272, N1 = 16 * 16, N3 = 12 * 32, N5 = 8 * 32, N6 = 16 * 32, N7 = 6 * 8;
    constexpr int NITEMS = N0 + 2 * N1 + 2 * N3 + N5 + N6 + 2 * N7, NSPLIT = N0 + 2 * N1;
    for (int it = (part ? NSPLIT : 0) + (NGW - 1 - gw); it < (part ? NITEMS : NSPLIT); it += NGW) {
        int r = it;
        if (r < N0) { transpose_item<1>(p.in[I_WIN], INC, 64 * (r / 272), 32 * (r % 272), WinT, D, 0, 0, scr, lane); continue; } r -= N0;
        if (r < N1) { transpose_item<0>(p.in[I_WK], XW, 64 * (r / 16), 32 * (r % 16), WinT, D, 8704, 0, scr, lane); continue; } r -= N1;
        if (r < N1) { transpose_item<0>(p.in[I_WV], XW, 64 * (r / 16), 32 * (r % 16), WinT, D, 9216, 0, scr, lane); continue; } r -= N1;
        if (r < N3) { transpose_item<0>(p.in[I_LWO], D, 64 * (r / 32), 32 * (r % 32), WcatT, 2048, 0, 0, scr, lane); continue; } r -= N3;
        if (r < N3) { transpose_item<0>(p.in[I_SWO], D, 64 * (r / 32), 32 * (r % 32), WcatT, 2048, 0, 768, scr, lane); continue; } r -= N3;
        if (r < N5) { transpose_item<0>(p.in[I_XWO], D, 64 * (r / 32), 32 * (r % 32), WcatT, 2048, 0, 1536, scr, lane); continue; } r -= N5;
        if (r < N6) { transpose_item<0>(p.in[I_WOUT], D, 64 * (r / 32), 32 * (r % 32), WoutT, D, 0, 0, scr, lane); continue; } r -= N6;
        if (r < N7) { const int blk = r / 8, q = r % 8; transpose_item<0>(p.in[I_WA] + (size_t)blk * 128 * 128, 128, 64 * (q / 4), 32 * (q % 4), WgT, 128, blk * 256, 0, scr, lane); continue; } r -= N7;
        { const int blk = r / 8, q = r % 8; transpose_item<0>(p.in[I_WX] + (size_t)blk * 128 * 128, 128, 64 * (q / 4), 32 * (q % 4), WgT, 128, blk * 256 + 128, 0, scr, lane); }
    }
    if (part) return;
    if (gw < 12) {
        const int ch = gw * 64 + lane; const float lam = p.in[I_LAM][ch];
        ((float*)(p.ws + WS_WG + 524288))[ch] = -8.0f * ((lam > 15.f) ? __expf(-lam) : log1pf(__expf(-lam))); }
    for (int m = gw; m < UROWS; m += NGW) {
        bf16_t* orow = U + (size_t)m * D;
        if (m < MP) rms_row(p.in[I_XP] + (size_t)m * D, p.in[I_NG], orow, lane);
        else if (m < MT) rms_row(p.in[I_XS] + (size_t)(m - MP) * D, p.in[I_NG], orow, lane);
        else if (m < MPAD) { u32x2* o8 = (u32x2*)orow + lane;
#pragma unroll
            for (int j = 0; j < 4; ++j) o8[64 * j] = (u32x2){0u, 0u}; }
        else rms_row(p.in[I_MEM] + (size_t)(m - MPAD) * D, p.in[I_MNG], orow, lane);
    }
}

struct Sched1 {
    int G, c;
    __device__ __forceinline__ bool next(int i, Unit& u) const {
        const int L = i * G + c; constexpr int nM = 65, nN = 34, nwg = nM * nN;
        if (L >= nwg + 32) return false;
        u.seg = 0;
        if (L < 32) { u.pm = 65 + (L >> 2); u.pn = 34 + (L & 3); return true; }
        int wgid = L - 32; { const int q = nwg / 8, r = nwg % 8, xcd = wgid % 8, off = wgid / 8; wgid = (xcd < r ? xcd * (q + 1) : r * (q + 1) + (xcd - r) * q) + off; }
        const int nig = 8 * nN, gid = wgid / nig, fm = gid * 8, gsz = (nM - fm) < 8 ? (nM - fm) : 8;
        u.pm = fm + ((wgid % nig) % gsz); u.pn = (wgid % nig) / gsz; return true;
    }
    __device__ __forceinline__ size_t a_off(const Unit& u) const { return (size_t)u.pm * 256 * D * 2; }
    __device__ __forceinline__ size_t b_off(const Unit& u) const { return (size_t)u.pn * 256 * D * 2; }
    __device__ __forceinline__ int nt(const Unit&) const { return D / 64; }
};
constexpr float QSCALE = 0.08838834764831845f * 1.4426950408889634f;
__device__ __forceinline__ int vt_pos(int m) { const int kl = m & 15; return (m & ~15) + 8 * ((kl >> 2) & 1) + 4 * (kl >> 3) + (kl & 3); }
struct Epi1 {
    static constexpr bool PERM = true;
    bf16_t* P; float* outK; float* outV; bf16_t* KB; bf16_t* VtB; const float* scw;
    __device__ __forceinline__ bool operator()(f32x4 (&acc)[2][2][4][2], const Unit& u, int wr, int wc, int fr, int fq) const {
        const int pn = u.pn; const int row0 = u.pm * 256 + wr * 64 + fr;
        if (pn >= 34) {
            const int mr0 = row0 - MPAD; const bool isV = pn >= 36;
#pragma unroll
            for (int ai = 0; ai < 2; ++ai)
#pragma unroll
                for (int m = 0; m < 4; ++m) { const int mr = mr0 + ai * 128 + m * 16;
#pragma unroll
                    for (int bj = 0; bj < 2; ++bj) { const int col = (pn - (isV ? 36 : 34)) * 256 + bj * 128 + wc * 32 + 8 * fq; const f32x4 v0 = acc[ai][bj][m][0], v1 = acc[ai][bj][m][1];
                        float* o = (isV ? outV : outK) + (size_t)mr * XW + col; *(f32x4*)o = v0; *(f32x4*)(o + 4) = v1;
                        if (!isV) { u32x4 w; w.x = cvt_pk_bf16(v0[0], v0[1]); w.y = cvt_pk_bf16(v0[2], v0[3]); w.z = cvt_pk_bf16(v1[0], v1[1]); w.w = cvt_pk_bf16(v1[2], v1[3]); *(u32x4*)(KB + (size_t)mr * XW + col) = w; }
                        else { const int b = mr >> 8, mm = mr & 255, h = col >> 7, d0 = col & 127; bf16_t* vt = VtB + ((size_t)(b * 4 + h) * 128 + d0) * 256 + vt_pos(mm);
                            const unsigned w0 = cvt_pk_bf16(v0[0], v0[1]), w1 = cvt_pk_bf16(v0[2], v0[3]), w2 = cvt_pk_bf16(v1[0], v1[1]), w3 = cvt_pk_bf16(v1[2], v1[3]);
                            vt[0] = (bf16_t)w0; vt[256] = (bf16_t)(w0 >> 16); vt[512] = (bf16_t)w1; vt[768] = (bf16_t)(w1 >> 16); vt[1024] = (bf16_t)w2; vt[1280] = (bf16_t)(w2 >> 16); vt[1536] = (bf16_t)w3; vt[1792] = (bf16_t)(w3 >> 16); } } }
            return false;
        }
        if (pn >= 6 && pn < 18) {
            const int ch0 = 64 * (pn - 6) + 16 * wc + 4 * fq;
            if (u.pm >= 64) {
#pragma unroll
                for (int ai = 0; ai < 2; ++ai)
#pragma unroll
                    for (int m = 0; m < 4; ++m) { const f32x4 sb = acc[ai][0][m][0], scg = acc[ai][0][m][1], sh = acc[ai][1][m][0], sg = acc[ai][1][m][1];
                        bf16_t* prow = P + (size_t)(row0 + ai * 128 + m * 16) * PLD;
                        u32x2 wc_, wg_;
                        wc_.x = cvt_pk_bf16(scg[0] * sh[0], scg[1] * sh[1]); wc_.y = cvt_pk_bf16(scg[2] * sh[2], scg[3] * sh[3]);
                        wg_.x = cvt_pk_bf16(silu(sg[0]) * sb[0], silu(sg[1]) * sb[1]); wg_.y = cvt_pk_bf16(silu(sg[2]) * sb[2], silu(sg[3]) * sb[3]);
                        *(u32x2*)(prow + PC_CIN + ch0) = wc_; *(u32x2*)(prow + PC_GB + ch0) = wg_; }
                return false;
            }
            const f32x4 w0 = *(const f32x4*)(scw + ch0), w1 = *(const f32x4*)(scw + LW + ch0), w2 = *(const f32x4*)(scw + 2 * LW + ch0);
#pragma unroll
            for (int ai = 0; ai < 2; ++ai) {
                f32x4 cprev = (f32x4){0.f, 0.f, 0.f, 0.f};
#pragma unroll
                for (int m = 0; m < 4; ++m) { const f32x4 sb = acc[ai][0][m][0], scg = acc[ai][0][m][1], sh = acc[ai][1][m][0], sg = acc[ai][1][m][1];
                    bf16_t* prow = P + (size_t)(row0 + ai * 128 + m * 16) * PLD;
                    const f32x4 cin = scg * sh; f32x4 gp, c1, c2;
#pragma unroll
                    for (int i = 0; i < 4; ++i) { gp[i] = silu(sg[i]) * sb[i];
                        const float v1 = (fr == 15) ? cprev[i] : cin[i], v2 = (fr >= 14) ? cprev[i] : cin[i];
                        c1[i] = __int_as_float(__builtin_amdgcn_update_dpp(0, __float_as_int(v1), 0x121, 0xf, 0xf, false));
                        c2[i] = __int_as_float(__builtin_amdgcn_update_dpp(0, __float_as_int(v2), 0x122, 0xf, 0xf, false)); }
                    const bool special = (m == 0 && fr < 2);
                    const f32x4 gb = gp * (w0 * c2 + w1 * c1 + w2 * cin);
                    const f32x4 o = special ? gp : gb;
                    u32x2 wg_; wg_.x = cvt_pk_bf16(o[0], o[1]); wg_.y = cvt_pk_bf16(o[2], o[3]);
                    *(u32x2*)(prow + PC_GB + ch0) = wg_;
                    if (special || (m == 3 && fr >= 14)) { u32x2 wc_; wc_.x = cvt_pk_bf16(cin[0], cin[1]); wc_.y = cvt_pk_bf16(cin[2], cin[3]); *(u32x2*)(prow + PC_CIN + ch0) = wc_; }
                    cprev = cin; }
            }
            return false;
        }
        int mode, dcol;
        if (pn < 3) { mode = 0; dcol = PC_LX + 256 * pn; }
        else if (pn < 6) { mode = 1; dcol = PC_GA + 256 * (pn - 3); }
        else if (pn < 20) { mode = 2; dcol = PC_Q + 256 * (pn - 18); }
        else if (pn < 22) { mode = 1; dcol = PC_GC + 256 * (pn - 20); }
        else { mode = 3; dcol = PC_G + 256 * (pn - 22); }
#define EPI1_STORE_LOOP(XF) do { _Pragma("unroll") for (int ai = 0; ai < 2; ++ai) _Pragma("unroll") for (int m = 0; m < 4; ++m) { \
            bf16_t* prow = P + (size_t)(row0 + ai * 128 + m * 16) * PLD + dcol + wc * 64 + 8 * fq; \
            _Pragma("unroll") for (int bj = 0; bj < 2; ++bj) { f32x4 v0 = acc[ai][bj][m][0], v1 = acc[ai][bj][m][1]; \
                _Pragma("unroll") for (int i = 0; i < 4; ++i) { v0[i] = XF(v0[i]); v1[i] = XF(v1[i]); } \
                u32x4 w; w.x = cvt_pk_bf16(v0[0], v0[1]); w.y = cvt_pk_bf16(v0[2], v0[3]); w.z = cvt_pk_bf16(v1[0], v1[1]); w.w = cvt_pk_bf16(v1[2], v1[3]); \
                *(u32x4*)(prow + bj * 32) = w; } } } while (0)
#define EPI1_ID(x) (x)
#define EPI1_SC(x) ((x) * QSCALE)
        if (mode == 0) EPI1_STORE_LOOP(EPI1_ID); else if (mode == 1) EPI1_STORE_LOOP(silu); else if (mode == 2) EPI1_STORE_LOOP(EPI1_SC); else EPI1_STORE_LOOP(sigm);
#undef EPI1_STORE_LOOP
#undef EPI1_ID
#undef EPI1_SC
        return false;
    }
};

struct Sched2 {
    int G, c, su0, su1;
    __device__ __forceinline__ bool next(int i, Unit& u) const {
        const int su = su0 + c + (i / 3) * G; if (su >= su1) return false;
        u.pm = su >> 2; u.pn = su & 3; u.seg = i % 3; return true;
    }
    __device__ __forceinline__ size_t a_off(const Unit& u) const { return ((size_t)u.pm * 256 * PLD + u.seg * 768) * 2; }
    __device__ __forceinline__ size_t b_off(const Unit& u) const { return ((size_t)u.pn * 256 * 2048 + u.seg * 768) * 2; }
    __device__ __forceinline__ int nt(const Unit& u) const { return u.seg < 2 ? 12 : 8; }
};
struct Epi2 {
    static constexpr bool PERM = true;
    bf16_t* P;
    __device__ __forceinline__ bool operator()(f32x4 (&acc)[2][2][4][2], const Unit& u, int wr, int wc, int fr, int fq) const {
        const int row0 = u.pm * 256 + wr * 64 + fr, col0 = u.pn * 256 + wc * 32 + 8 * fq, seg = u.seg;
#pragma unroll
        for (int ai = 0; ai < 2; ++ai) {
            u32x4 nw[4][2], dw[4][2];
#pragma unroll
            for (int m = 0; m < 4; ++m) { const bf16_t* prow = P + (size_t)(row0 + ai * 128 + m * 16) * PLD + PC_G + seg * 1024 + col0;
#pragma unroll
                for (int bj = 0; bj < 2; ++bj) { nw[m][bj] = *(const u32x4*)(prow + bj * 128); if (seg < 2) dw[m][bj] = *(const u32x4*)(prow + 1024 + bj * 128); } }
#pragma unroll
            for (int m = 0; m < 4; ++m) { bf16_t* prow = P + (size_t)(row0 + ai * 128 + m * 16) * PLD;
#pragma unroll
                for (int bj = 0; bj < 2; ++bj) { const int col = col0 + bj * 128;
                    float num[8], den[8];
                    unpack8(nw[m][bj], num);
                    if (seg < 2) { unpack8(dw[m][bj], den);
#pragma unroll
                        for (int i = 0; i < 8; ++i) num[i] = num[i] * __builtin_amdgcn_rcpf(den[i]); }
                    f32x4 v0 = acc[ai][bj][m][0], v1 = acc[ai][bj][m][1];
#pragma unroll
                    for (int i = 0; i < 4; ++i) { v0[i] *= num[i]; v1[i] *= num[4 + i]; }
                    if (seg < 2) { acc[ai][bj][m][0] = v0; acc[ai][bj][m][1] = v1; }
                    else { u32x4 w; w.x = cvt_pk_bf16(v0[0], v0[1]); w.y = cvt_pk_bf16(v0[2], v0[3]); w.z = cvt_pk_bf16(v1[0], v1[1]); w.w = cvt_pk_bf16(v1[2], v1[3]);
                        *(u32x4*)(prow + PC_MRG + col) = w; } } }
            asm volatile("" ::: "memory"); }
        return seg < 2;
    }
};
struct Sched3 {
    int G, c, su0, su1;
    __device__ __forceinline__ bool next(int i, Unit& u) const { const int su = su0 + c + i * G; if (su >= su1) return false; u.pm = su >> 2; u.pn = su & 3; u.seg = 0; return true; }
    __device__ __forceinline__ size_t a_off(const Unit& u) const { return ((size_t)u.pm * 256 * PLD + PC_MRG) * 2; }
    __device__ __forceinline__ size_t b_off(const Unit& u) const { return (size_t)u.pn * 256 * D * 2; }
    __device__ __forceinline__ int nt(const Unit&) const { return D / 64; }
};
struct Epi3 {
    static constexpr bool PERM = false;
    const float* xp; const float* xs; float* out; float* rss;
    __device__ __forceinline__ bool operator()(f32x4 (&acc)[2][2][4][2], const Unit& u, int wr, int wc, int fr, int fq) const {
        const int row0 = u.pm * 256 + wr * 64 + fr, col0 = u.pn * 256 + wc * 32 + 4 * fq;
#pragma unroll
        for (int ai = 0; ai < 2; ++ai)
#pragma unroll
            for (int mp = 0; mp < 2; ++mp) {
                f32x4 xv[2][2][2];
#pragma unroll
                for (int mm = 0; mm < 2; ++mm) { const int row = row0 + ai * 128 + (2 * mp + mm) * 16; const bool ok = row < MT;
                    const float* xrow = (row < MP ? xp + (size_t)row * D : xs + (size_t)((ok ? row : MP) - MP) * D) + col0;
#pragma unroll
                    for (int bj = 0; bj < 2; ++bj)
#pragma unroll
                        for (int n = 0; n < 2; ++n) xv[mm][bj][n] = *(const f32x4*)(xrow + bj * 128 + n * 16); }
#pragma unroll
                for (int mm = 0; mm < 2; ++mm) { const int m = 2 * mp + mm; const int row = row0 + ai * 128 + m * 16; const bool ok = row < MT; float ss = 0.f;
                    float* orow = out + (size_t)row * D + col0;
#pragma unroll
                    for (int bj = 0; bj < 2; ++bj)
#pragma unroll
                        for (int n = 0; n < 2; ++n) { const f32x4 v = xv[mm][bj][n] + acc[ai][bj][m][n];
                            if (ok) *(f32x4*)(orow + bj * 128 + n * 16) = v; ss += (v[0] * v[0] + v[1] * v[1]) + (v[2] * v[2] + v[3] * v[3]); }
                    ss += __shfl_xor(ss, 16); ss += __shfl_xor(ss, 32);
                    if (ok && fq == 0) rss[(size_t)row * 16 + u.pn * 4 + wc] = ss; }
                asm volatile("" ::: "memory"); }
        return false;
    }
};

struct Epi3F {
    static constexpr bool PERM = false;
    const float* xp; float* out; const float* fg; float* xbuf; unsigned* cnt; LAS unsigned char* lds;
    __device__ __forceinline__ bool operator()(f32x4 (&acc)[2][2][4][2], const Unit& u, int wr, int wc, int fr, int fq) const {
        const int tid = threadIdx.x, lane = tid & 63, wid = tid >> 6;
        LAS float* PT = (LAS float*)(lds + 131072); LAS float* ST = PT + 1024;
        const int row0 = u.pm * 256 + wr * 64 + fr, col0 = u.pn * 256 + wc * 32 + 4 * fq;
#pragma unroll
        for (int ai = 0; ai < 2; ++ai)
#pragma unroll
            for (int mp = 0; mp < 2; ++mp) {
                f32x4 xv[2][2][2];
#pragma unroll
                for (int mm = 0; mm < 2; ++mm) { const float* xrow = xp + (size_t)(row0 + ai * 128 + (2 * mp + mm) * 16) * D + col0;
#pragma unroll
                    for (int bj = 0; bj < 2; ++bj)
#pragma unroll
                        for (int n = 0; n < 2; ++n) xv[mm][bj][n] = *(const f32x4*)(xrow + bj * 128 + n * 16); }
#pragma unroll
                for (int mm = 0; mm < 2; ++mm) { const int m = 2 * mp + mm; float ss = 0.f;
#pragma unroll
                    for (int bj = 0; bj < 2; ++bj)
#pragma unroll
                        for (int n = 0; n < 2; ++n) { const f32x4 v = xv[mm][bj][n] + acc[ai][bj][m][n]; acc[ai][bj][m][n] = v; ss += (v[0] * v[0] + v[1] * v[1]) + (v[2] * v[2] + v[3] * v[3]); }
                    ss += __shfl_xor(ss, 16); ss += __shfl_xor(ss, 32);
                    if (fq == 0) PT[(ai * 128 + wr * 64 + m * 16 + fr) * 4 + wc] = ss; }
                }
        __syncthreads();
        if (tid < 256) { const f32x4 pt = *(const LAS f32x4*)(PT + tid * 4); const float t = (pt[0] + pt[1]) + (pt[2] + pt[3]);
            __hip_atomic_store(xbuf + ((size_t)u.pm * 256 + tid) * 4 + u.pn, t, __ATOMIC_RELAXED, __HIP_MEMORY_SCOPE_AGENT);
            asm volatile("s_waitcnt vmcnt(0)" ::: "memory");
            if (lane == 0) __hip_atomic_fetch_add(cnt + 64 * u.pm, 1u, __ATOMIC_RELAXED, __HIP_MEMORY_SCOPE_AGENT); }
        if (wid == 0) { unsigned sp = 0;
            while ((unsigned)__builtin_amdgcn_readfirstlane(__hip_atomic_load(cnt + 64 * u.pm, __ATOMIC_RELAXED, __HIP_MEMORY_SCOPE_AGENT)) < 16u) { __builtin_amdgcn_s_sleep(2); if (++sp > (1u << 22)) break; }
            __builtin_amdgcn_fence(__ATOMIC_ACQUIRE, "agent"); }
        asm volatile("s_waitcnt vmcnt(0)" ::: "memory");
        __syncthreads();
        if (tid < 256) { const float* sl = xbuf + ((size_t)u.pm * 256 + tid) * 4; float t = 0.f;
#pragma unroll
            for (int k = 0; k < 4; ++k) t += __hip_atomic_load(sl + k, __ATOMIC_RELAXED, __HIP_MEMORY_SCOPE_AGENT);
            ST[tid] = 1.f / sqrtf(t * (1.f / D) + EPS); }
        __syncthreads();
        f32x4 gg[2][2];
#pragma unroll
        for (int bj = 0; bj < 2; ++bj)
#pragma unroll
            for (int n = 0; n < 2; ++n) gg[bj][n] = *(const f32x4*)(fg + col0 + bj * 128 + n * 16);
#pragma unroll
        for (int ai = 0; ai < 2; ++ai)
#pragma unroll
            for (int m = 0; m < 4; ++m) { const int rl = ai * 128 + wr * 64 + m * 16 + fr; const float rs = ST[rl]; float* orow = out + (size_t)(u.pm * 256 + rl) * D + col0;
#pragma unroll
                for (int bj = 0; bj < 2; ++bj)
#pragma unroll
                    for (int n = 0; n < 2; ++n) __builtin_nontemporal_store(acc[ai][bj][m][n] * rs * gg[bj][n], (f32x4*)(orow + bj * 128 + n * 16)); }
        return false;
    }
};

__device__ __forceinline__ void attn_prompt_unit(LAS unsigned char* lds, bf16_t* P, const bf16_t* KB, const bf16_t* VtB, int unit, bool st = true) {
    const int tid = threadIdx.x, lane = tid & 63, wave = tid >> 6, r32 = lane & 31, hi = lane >> 5;
    const int b = unit >> 5, h = (unit >> 3) & 3, qb = unit & 7;
    LAS unsigned char* ldsK = lds; LAS unsigned char* ldsV = lds + 256 * 272;
    __syncthreads();
    for (int i = tid; i < 256 * 16; i += 512) { const int kv = i >> 4, c = i & 15; *(LAS u32x4*)(ldsK + kv * 272 + c * 16) = *(const u32x4*)(KB + (size_t)(b * 256 + kv) * XW + h * 128 + c * 8); }
    for (int i = tid; i < 128 * 32; i += 512) { const int d = i >> 5, c = i & 31; *(LAS u32x4*)(ldsV + d * 528 + c * 16) = *(const u32x4*)(VtB + ((size_t)(b * 4 + h) * 128 + d) * 256 + c * 8); }
    const size_t tok = (size_t)b * SEQ + qb * 256 + wave * 32;
    bf16x8 qf[8];
    { const bf16_t* qrow = P + (tok + r32) * PLD + PC_Q + h * 128 + 8 * hi;
#pragma unroll
        for (int s = 0; s < 8; ++s) qf[s] = *(const bf16x8*)(qrow + 16 * s); }
    __syncthreads();
    f32x16 sacc[8];
#pragma unroll
    for (int t = 0; t < 8; ++t) {
#pragma unroll
        for (int r = 0; r < 16; ++r) sacc[t][r] = 0.f;
#pragma unroll
        for (int s = 0; s < 8; ++s) { const bf16x8 kf = *(const LAS bf16x8*)(ldsK + (32 * t + r32) * 272 + (16 * s + 8 * hi) * 2); sacc[t] = __builtin_amdgcn_mfma_f32_32x32x16_bf16(kf, qf[s], sacc[t], 0, 0, 0); }
    }
    float mx = -3.0e38f;
#pragma unroll
    for (int t = 0; t < 8; ++t)
#pragma unroll
        for (int r = 0; r < 16; ++r) mx = fmaxf(mx, sacc[t][r]);
    mx = fmaxf(mx, __shfl_xor(mx, 32));
    float sum = 0.f;
#pragma unroll
    for (int t = 0; t < 8; ++t)
#pragma unroll
        for (int r = 0; r < 16; ++r) { const float e = __builtin_amdgcn_exp2f(sacc[t][r] - mx); sacc[t][r] = e; sum += e; }
    sum += __shfl_xor(sum, 32);
    const float inv = __builtin_amdgcn_rcpf(sum);
#pragma unroll
    for (int t = 0; t < 8; ++t)
#pragma unroll
        for (int r = 0; r < 16; ++r) sacc[t][r] *= inv;
#pragma unroll 1
    for (int dp = 0; dp < 2; ++dp) {
        f32x16 o[2];
#pragma unroll
        for (int dt = 0; dt < 2; ++dt)
#pragma unroll
            for (int r = 0; r < 16; ++r) o[dt][r] = 0.f;
        const LAS unsigned char* vbase = ldsV + (64 * dp + r32) * 528 + 16 * hi;
#pragma unroll
        for (int t = 0; t < 8; ++t) {
#pragma unroll
            for (int s2 = 0; s2 < 2; ++s2) {
                u32x4 pw; pw.x = cvt_pk_bf16(sacc[t][8 * s2 + 0], sacc[t][8 * s2 + 1]); pw.y = cvt_pk_bf16(sacc[t][8 * s2 + 2], sacc[t][8 * s2 + 3]);
                pw.z = cvt_pk_bf16(sacc[t][8 * s2 + 4], sacc[t][8 * s2 + 5]); pw.w = cvt_pk_bf16(sacc[t][8 * s2 + 6], sacc[t][8 * s2 + 7]);
                const bf16x8 pa = __builtin_bit_cast(bf16x8, pw);
#pragma unroll
                for (int dt = 0; dt < 2; ++dt) { const bf16x8 vf = *(const LAS bf16x8*)(vbase + dt * 32 * 528 + (32 * t + 16 * s2) * 2); o[dt] = __builtin_amdgcn_mfma_f32_32x32x16_bf16(vf, pa, o[dt], 0, 0, 0); }
            }
            __builtin_amdgcn_sched_barrier(0);
        }
        bf16_t* grow = P + (tok + r32) * PLD + PC_GC + h * 128 + 64 * dp + 8 * hi;
        __builtin_amdgcn_sched_barrier(0);
        u32x4 gw[2][2];
#pragma unroll
        for (int dt = 0; dt < 2; ++dt)
#pragma unroll
            for (int pr = 0; pr < 2; ++pr) gw[dt][pr] = *(const u32x4*)(grow + 32 * dt + 16 * pr);
#pragma unroll
        for (int dt = 0; dt < 2; ++dt)
#pragma unroll
            for (int pr = 0; pr < 2; ++pr) { float v[8], g[8]; unpack8(gw[dt][pr], g);
#pragma unroll
                for (int i = 0; i < 4; ++i) { const auto rr = __builtin_amdgcn_permlane32_swap(__float_as_uint(o[dt][8 * pr + i]), __float_as_uint(o[dt][8 * pr + 4 + i]), false, false);
                    v[i] = __uint_as_float(rr[0]); v[4 + i] = __uint_as_float(rr[1]); }
#pragma unroll
                for (int i = 0; i < 8; ++i) v[i] *= g[i];
                const u32x4 w = pack8(v); if (st) *(u32x4*)(grow + 32 * dt + 16 * pr) = w; else asm volatile("" :: "v"(w)); }
        __builtin_amdgcn_sched_barrier(0);
    }
}
__device__ __forceinline__ void attn_sample_unit(LAS unsigned char* lds, bf16_t* P, const float* ck, const float* cv, int unit, bool st = true) {
    const int tid = threadIdx.x, lane = tid & 63, wave = tid >> 6, l32 = lane & 31, half = lane >> 5;
    const int b = unit >> 2, h = unit & 3;
    LAS float* sc = (LAS float*)lds; LAS float* pn = sc + 256; LAS float* red = pn + 256;
    const bf16_t* qrow = P + (size_t)(MP + b) * PLD + PC_Q + h * 128;
    float q4[4]; { const u32x2 w = *(const u32x2*)(qrow + 4 * l32); q4[0] = bflo(w.x); q4[1] = bfhi(w.x); q4[2] = bflo(w.y); q4[3] = bfhi(w.y); }
    const float* kb = ck + ((size_t)b * 256 * 4 + h) * 128 + 4 * l32;
    const int d4 = tid & 31, mg = tid >> 5; const float* vb = cv + ((size_t)b * 256 * 4 + h) * 128 + 4 * d4;
    f32x4 k4[16], v4[16];
#pragma unroll
    for (int ps = 0; ps < 16; ++ps) k4[ps] = __builtin_nontemporal_load((const f32x4*)(kb + (size_t)(ps * 16 + wave * 2 + half) * 512));
#pragma unroll
    for (int i = 0; i < 16; ++i) v4[i] = __builtin_nontemporal_load((const f32x4*)(vb + (size_t)(mg * 16 + i) * 512));
    __syncthreads();
#pragma unroll
    for (int ps = 0; ps < 16; ++ps) { const int m = ps * 16 + wave * 2 + half;
        float s = (k4[ps][0] * q4[0] + k4[ps][1] * q4[1]) + (k4[ps][2] * q4[2] + k4[ps][3] * q4[3]);
        s += __shfl_xor(s, 1); s += __shfl_xor(s, 2); s += __shfl_xor(s, 4); s += __shfl_xor(s, 8); s += __shfl_xor(s, 16);
        if (l32 == 0) sc[m] = s; }
    __syncthreads();
    if (wave == 0) { float v[4]; float mx = -3.0e38f;
#pragma unroll
        for (int j = 0; j < 4; ++j) { v[j] = sc[lane + 64 * j]; mx = fmaxf(mx, v[j]); }
        mx = wave_max(mx); float sm = 0.f;
#pragma unroll
        for (int j = 0; j < 4; ++j) { v[j] = __builtin_amdgcn_exp2f(v[j] - mx); sm += v[j]; }
        sm = wave_sum(sm); const float inv = 1.f / sm;
#pragma unroll
        for (int j = 0; j < 4; ++j) pn[lane + 64 * j] = v[j] * inv; }
    __syncthreads();
    { f32x4 a = (f32x4){0.f, 0.f, 0.f, 0.f};
#pragma unroll
        for (int i = 0; i < 16; ++i) a += v4[i] * pn[mg * 16 + i];
        *(LAS f32x4*)(red + mg * 128 + 4 * d4) = a; }
    __syncthreads();
    if (tid < 128) { float o = 0.f;
#pragma unroll
        for (int g = 0; g < 16; ++g) o += red[g * 128 + tid];
        bf16_t* gp = P + (size_t)(MP + b) * PLD + PC_GC + h * 128 + tid; const float gv = bf2f(*gp); if (st) *gp = (bf16_t)(cvt_pk_bf16(o * gv, 0.f) & 0xffffu); }
}
__device__ __forceinline__ void attn_sample_phase(LAS unsigned char* lds, bf16_t* P, const float* ck, const float* cv, int u0, int nunits, int G) {
    const int tid = threadIdx.x, lane = tid & 63, wave = tid >> 6, l32 = lane & 31, half = lane >> 5;
    LAS float* sc = (LAS float*)lds; LAS float* pn = sc + 256; LAS float* red = pn + 256;
    const int d4 = tid & 31, mg = tid >> 5;
    if (u0 >= nunits) return;
    f32x4 k4[16], v4[16]; float q4[4];
#define AS_LOADK(uu) do { const int _b = (uu) >> 2, _h = (uu) & 3; const u32x2 _w = *(const u32x2*)(P + (size_t)(MP + _b) * PLD + PC_Q + _h * 128 + 4 * l32); \
        q4[0] = bflo(_w.x); q4[1] = bfhi(_w.x); q4[2] = bflo(_w.y); q4[3] = bfhi(_w.y); const float* _kb = ck + ((size_t)_b * 256 * 4 + _h) * 128 + 4 * l32; \
        _Pragma("unroll") for (int ps = 0; ps < 16; ++ps) k4[ps] = __builtin_nontemporal_load((const f32x4*)(_kb + (size_t)(ps * 16 + wave * 2 + half) * 512)); } while (0)
#define AS_LOADV(uu) do { const int _b = (uu) >> 2, _h = (uu) & 3; const float* _vb = cv + ((size_t)_b * 256 * 4 + _h) * 128 + 4 * d4; \
        _Pragma("unroll") for (int i = 0; i < 16; ++i) v4[i] = __builtin_nontemporal_load((const f32x4*)(_vb + (size_t)(mg * 16 + i) * 512)); } while (0)
    AS_LOADK(u0); AS_LOADV(u0);
    for (int u = u0; u < nunits; u += G) {
        const int b = u >> 2, h = u & 3; const bool hn = (u + G) < nunits;
        float sv[16];
#pragma unroll
        for (int ps = 0; ps < 16; ++ps) { float s = (k4[ps][0] * q4[0] + k4[ps][1] * q4[1]) + (k4[ps][2] * q4[2] + k4[ps][3] * q4[3]);
            s += __shfl_xor(s, 1); s += __shfl_xor(s, 2); s += __shfl_xor(s, 4); s += __shfl_xor(s, 8); s += __shfl_xor(s, 16); sv[ps] = s; }
        if (hn) AS_LOADK(u + G);
        __syncthreads();
#pragma unroll
        for (int ps = 0; ps < 16; ++ps) if (l32 == 0) sc[ps * 16 + wave * 2 + half] = sv[ps];
        __syncthreads();
        if (wave == 0) { float v[4]; float mx = -3.0e38f;
#pragma unroll
            for (int j = 0; j < 4; ++j) { v[j] = sc[lane + 64 * j]; mx = fmaxf(mx, v[j]); }
            mx = wave_max(mx); float sm = 0.f;
#pragma unroll
            for (int j = 0; j < 4; ++j) { v[j] = __builtin_amdgcn_exp2f(v[j] - mx); sm += v[j]; }
            sm = wave_sum(sm); const float inv = 1.f / sm;
#pragma unroll
            for (int j = 0; j < 4; ++j) pn[lane + 64 * j] = v[j] * inv; }
        __syncthreads();
        { f32x4 a = (f32x4){0.f, 0.f, 0.f, 0.f};
#pragma unroll
            for (int i = 0; i < 16; ++i) a += v4[i] * pn[mg * 16 + i];
            *(LAS f32x4*)(red + mg * 128 + 4 * d4) = a; }
        if (hn) AS_LOADV(u + G);
        __syncthreads();
        if (tid < 128) { float o = 0.f;
#pragma unroll
            for (int g = 0; g < 16; ++g) o += red[g * 128 + tid];
            bf16_t* gp = P + (size_t)(MP + b) * PLD + PC_GC + h * 128 + tid; const float gv = bf2f(*gp); *gp = (bf16_t)(cvt_pk_bf16(o * gv, 0.f) & 0xffffu); }
    }
#undef AS_LOADK
#undef AS_LOADV
}
constexpr int L_XA = 0, L_RAW0 = 17408, L_RAW1 = 34816, L_A = 52224, L_B = L_A + 33792, L_LRU_END = L_B + 33792;
static_assert(L_LRU_END <= 131072, "LRU LDS");
template <int MODE>
__device__ __forceinline__ void lru_phase(LAS unsigned char* lds, const Params& p, bf16_t* P, const bf16_t* WgT, float* agg, bf16_t* CG, int u0, int nunits, int G) {
    const int tid = threadIdx.x, lane = tid & 63, wave = tid >> 6;
    LAS float* LA = (LAS float*)(lds + L_A); LAS float* LB = (LAS float*)(lds + L_B);
    const float* cw = p.in[I_CW]; const float* cb = p.in[I_CB];
    const int ch8 = tid & 15, tl = tid >> 4, col = lane & 15, quad = lane >> 4;
    constexpr int NMT = (MODE == 2) ? 2 : 4, NRR = (MODE == 2) ? 1 : 2, UR = 16 * NMT;
    u32x4 pre[3];
    int buf = 0;
    __syncthreads();
    if (MODE != 2 && u0 < nunits) {
        const int n = u0 % 6, c = (u0 / 6) % NCH, b = u0 / (6 * NCH), t0 = c * TC;
#pragma unroll
        for (int k = 0; k < 3; ++k) { const int i = tid + 512 * k; const int r = i >> 4, c16 = i & 15, t = t0 - 3 + r; pre[k] = (u32x4){0u, 0u, 0u, 0u};
            if (i < 67 * 16 && t >= 0) pre[k] = *(const u32x4*)(P + ((size_t)b * SEQ + t) * PLD + PC_LX + n * 128 + 8 * c16); }
#pragma unroll
        for (int k = 0; k < 3; ++k) { const int i = tid + 512 * k; if (i < 67 * 16) *(LAS u32x4*)(lds + L_RAW0 + i * 16) = pre[k]; }
    }
    for (int u = u0; u < nunits; u += G, buf ^= 1) {
        int b, c, n, t0; size_t tokbase;
        if (MODE == 2) { n = u % 6; c = u / 6; b = 0; t0 = 0; tokbase = (size_t)MP + UR * c; }
        else { n = u % 6; c = (u / 6) % NCH; b = u / (6 * NCH); t0 = c * TC; tokbase = (size_t)b * SEQ + t0; }
        const LAS bf16_t* RAW = (const LAS bf16_t*)(lds + (buf ? L_RAW1 : L_RAW0));
        const int chg8 = n * 128 + 8 * ch8;
        float w[4][8], bias[8];
#pragma unroll
        for (int k = 0; k < 4; ++k) { const f32x4 a = *(const f32x4*)(cw + k * LW + chg8), bb = *(const f32x4*)(cw + k * LW + chg8 + 4);
            w[k][0] = a[0]; w[k][1] = a[1]; w[k][2] = a[2]; w[k][3] = a[3]; w[k][4] = bb[0]; w[k][5] = bb[1]; w[k][6] = bb[2]; w[k][7] = bb[3]; }
        { const f32x4 a = *(const f32x4*)(cb + chg8), bb = *(const f32x4*)(cb + chg8 + 4); bias[0] = a[0]; bias[1] = a[1]; bias[2] = a[2]; bias[3] = a[3]; bias[4] = bb[0]; bias[5] = bb[1]; bias[6] = bb[2]; bias[7] = bb[3]; }
        __syncthreads();
#pragma unroll
        for (int rr = 0; rr < NRR; ++rr) { const int tt = tl + 32 * rr; float xc[8];
#pragma unroll
            for (int j = 0; j < 8; ++j) xc[j] = bias[j];
            if (MODE != 2) {
#pragma unroll
                for (int k = 0; k < 4; ++k) { const u32x4 xw = *(const LAS u32x4*)(RAW + (tt + k) * 128 + 8 * ch8); float x[8]; unpack8(xw, x);
#pragma unroll
                    for (int j = 0; j < 8; ++j) xc[j] += w[k][j] * x[j];
                    if (k == 3 && c == NCH - 1 && tt >= 61) { float* o = p.out + O_PLC + ((size_t)b * 3 + (tt - 61)) * LW + chg8; *(f32x4*)o = (f32x4){x[0], x[1], x[2], x[3]}; *(f32x4*)(o + 4) = (f32x4){x[4], x[5], x[6], x[7]}; } }
            } else {
                const int smp = UR * c + tt; const float* sl = p.in[I_SLC] + (size_t)smp * 3 * LW + chg8; float* so = p.out + O_SLC + (size_t)smp * 3 * LW + chg8;
#pragma unroll
                for (int k = 0; k < 3; ++k) { const f32x4 a = *(const f32x4*)(sl + k * LW), bb = *(const f32x4*)(sl + k * LW + 4);
                    const float x[8] = {a[0], a[1], a[2], a[3], bb[0], bb[1], bb[2], bb[3]};
#pragma unroll
                    for (int j = 0; j < 8; ++j) xc[j] += w[k][j] * x[j];
                    if (k > 0) { *(f32x4*)(so + (k - 1) * LW) = a; *(f32x4*)(so + (k - 1) * LW + 4) = bb; } }
                float x[8]; unpack8(*(const u32x4*)(P + (tokbase + tt) * PLD + PC_LX + chg8), x);
#pragma unroll
                for (int j = 0; j < 8; ++j) xc[j] += w[3][j] * x[j];
                *(f32x4*)(so + 2 * LW) = (f32x4){x[0], x[1], x[2], x[3]}; *(f32x4*)(so + 2 * LW + 4) = (f32x4){x[4], x[5], x[6], x[7]};
            }
            *(LAS u32x4*)(lds + L_XA + tt * 272 + ch8 * 16) = pack8(xc); }
        const int d = 16 * wave + col, chg = n * 128 + d;
        const bf16_t* wrow = WgT + ((size_t)n * 256 + d) * 128 + 8 * quad;
        bf16x8 bwa[4], bwx[4];
#pragma unroll
        for (int ks = 0; ks < 4; ++ks) { bwa[ks] = *(const bf16x8*)(wrow + 32 * ks); bwx[ks] = *(const bf16x8*)(wrow + 128 * 128 + 32 * ks); }
        const float bav = p.in[I_BA][chg], bxv = p.in[I_BX][chg], cl = ((const float*)(p.ws + WS_WG + 524288))[chg];
        const float bav2 = -1.4426950408889634f * bav, bxv2 = -1.4426950408889634f * bxv, cl2 = 1.4426950408889634f * cl;
        __syncthreads();
        const int un = u + G; const bool hn = (MODE != 2) && (un < nunits);
        if (hn) { const int n2 = un % 6, c2 = (un / 6) % NCH, b2 = un / (6 * NCH), t02 = c2 * TC;
#pragma unroll
            for (int k = 0; k < 3; ++k) { const int i = tid + 512 * k; const int r = i >> 4, c16 = i & 15, t = t02 - 3 + r; pre[k] = (u32x4){0u, 0u, 0u, 0u};
                if (i < 67 * 16 && t >= 0) pre[k] = *(const u32x4*)(P + ((size_t)b2 * SEQ + t) * PLD + PC_LX + n2 * 128 + 8 * c16); } }
        u32x4 slw[NRR];
#pragma unroll
        for (int rr = 0; rr < NRR; ++rr) slw[rr] = *(const u32x4*)(P + (tokbase + tl + 32 * rr) * PLD + PC_GA + chg8);
        f32x4 aa[NMT], ax[NMT];
#pragma unroll
        for (int m = 0; m < NMT; ++m) { aa[m] = (f32x4){0.f, 0.f, 0.f, 0.f}; ax[m] = (f32x4){0.f, 0.f, 0.f, 0.f}; }
#pragma unroll
        for (int ks = 0; ks < 4; ++ks)
#pragma unroll
            for (int m = 0; m < NMT; ++m) { const bf16x8 af = *(const LAS bf16x8*)(lds + L_XA + (16 * m + col) * 272 + (32 * ks + 8 * quad) * 2);
                aa[m] = __builtin_amdgcn_mfma_f32_16x16x32_bf16(af, bwa[ks], aa[m], 0, 0, 0); ax[m] = __builtin_amdgcn_mfma_f32_16x16x32_bf16(af, bwx[ks], ax[m], 0, 0, 0); }
#pragma unroll
        for (int m = 0; m < NMT; ++m)
#pragma unroll
            for (int r = 0; r < 4; ++r) { const int t = 16 * m + 4 * quad + r;
                const float rg = __builtin_amdgcn_rcpf(1.f + __builtin_amdgcn_exp2f(__builtin_fmaf(aa[m][r], -1.4426950408889634f, bav2)));
                const float ig = __builtin_amdgcn_rcpf(1.f + __builtin_amdgcn_exp2f(__builtin_fmaf(ax[m][r], -1.4426950408889634f, bxv2)));
                const float a = __builtin_amdgcn_exp2f(cl2 * rg);
                const float em = __builtin_fmaf(-a, a, 1.0f);
                const float mult = __builtin_amdgcn_sqrtf(fmaxf(em, 0.f)); const float xcv = bf2f(*(const LAS bf16_t*)(lds + L_XA + t * 272 + d * 2));
                aa[m][r] = a; ax[m][r] = mult * ig * xcv; }
        if (MODE == 2) {
            const float* h0 = p.in[I_SH]; float* ho = p.out + O_SH;
#pragma unroll
            for (int m = 0; m < NMT; ++m)
#pragma unroll
                for (int r = 0; r < 4; ++r) { const int t = 16 * m + 4 * quad + r; const size_t idx = (size_t)(UR * c + t) * LW + chg; const float h = aa[m][r] * h0[idx] + ax[m][r]; ho[idx] = h; LB[t * 132 + d] = h; }
        } else {
            float cpc = 1.f, hc = 0.f;
#pragma unroll
            for (int m = 0; m < NMT; ++m) {
                float A = 1.f, H = 0.f;
#pragma unroll
                for (int r = 0; r < 4; ++r) { H = aa[m][r] * H + ax[m][r]; A *= aa[m][r]; }
                float Ai = A, Hi = H;
                { const float Ap = __shfl_up(Ai, 16), Hp = __shfl_up(Hi, 16); if (quad >= 1) { Hi = Ai * Hp + Hi; Ai = Ai * Ap; } }
                { const float Ap = __shfl_up(Ai, 32), Hp = __shfl_up(Hi, 32); if (quad >= 2) { Hi = Ai * Hp + Hi; Ai = Ai * Ap; } }
                float Ae = __shfl_up(Ai, 16), He = __shfl_up(Hi, 16); if (quad == 0) { Ae = 1.f; He = 0.f; }
                const float At = __shfl(Ai, 48 + col), Ht = __shfl(Hi, 48 + col);
                float cp = Ae * cpc, h = Ae * hc + He;
#pragma unroll
                for (int r = 0; r < 4; ++r) { const int t = 16 * m + 4 * quad + r; h = aa[m][r] * h + ax[m][r]; cp *= aa[m][r]; LB[t * 132 + d] = h; LA[t * 132 + d] = cp; }
                hc = At * hc + Ht; cpc = At * cpc;
            }
            if (quad == 0) { float* ag = agg + (((size_t)b * NCH + c) * LW + chg) * 2; *(float2*)ag = make_float2(cpc, hc); }
        }
        if (hn) {
#pragma unroll
            for (int k = 0; k < 3; ++k) { const int i = tid + 512 * k; if (i < 67 * 16) *(LAS u32x4*)(lds + (buf ? L_RAW0 : L_RAW1) + i * 16) = pre[k]; } }
        __syncthreads();
#pragma unroll
        for (int rr = 0; rr < NRR; ++rr) { const int tt = tl + 32 * rr; bf16_t* gp = P + (tokbase + tt) * PLD + PC_GA + chg8;
            float g[8]; unpack8(slw[rr], g); const f32x4 h0 = *(const LAS f32x4*)(LB + tt * 132 + 8 * ch8), h1 = *(const LAS f32x4*)(LB + tt * 132 + 8 * ch8 + 4);
            if (MODE == 0) { const f32x4 c0 = *(const LAS f32x4*)(LA + tt * 132 + 8 * ch8), c1 = *(const LAS f32x4*)(LA + tt * 132 + 8 * ch8 + 4);
                float cgv[8] = {g[0] * c0[0], g[1] * c0[1], g[2] * c0[2], g[3] * c0[3], g[4] * c1[0], g[5] * c1[1], g[6] * c1[2], g[7] * c1[3]};
                *(u32x4*)(CG + (tokbase + tt) * LW + chg8) = pack8(cgv); }
            g[0] *= h0[0]; g[1] *= h0[1]; g[2] *= h0[2]; g[3] *= h0[3]; g[4] *= h1[0]; g[5] *= h1[1]; g[6] *= h1[2]; g[7] *= h1[3];
            *(u32x4*)gp = pack8(g); }
    }
}
__device__ __forceinline__ void lru_fix_item(LAS unsigned char* lds, const Params& p, bf16_t* P, const bf16_t* CG, const float* agg, int item) {
    const int tid = threadIdx.x; const int b = item >> 5, cq = (item >> 2) & 7, ns = item & 3;
    LAS float* HIN = (LAS float*)lds;
    __syncthreads();
    if (tid < 192) { const int ch = 192 * ns + tid; const float* ag = agg + ((size_t)b * NCH * LW + ch) * 2; float h = 0.f;
        const int cend = (cq == 7) ? NCH : 4 * cq + 4;
        for (int c0 = 0; c0 < cend; c0 += 8) { float A8[8], H8[8];
#pragma unroll
            for (int j = 0; j < 8; ++j) { A8[j] = 1.f; H8[j] = 0.f; if (c0 + j < cend) { const float2 v = *(const float2*)(ag + (size_t)(c0 + j) * LW * 2); A8[j] = v.x; H8[j] = v.y; } }
#pragma unroll
            for (int j = 0; j < 8; ++j) { const int cc = c0 + j; if (cc >= 4 * cq && cc < 4 * cq + 4) HIN[(cc - 4 * cq) * 192 + tid] = h; h = A8[j] * h + H8[j]; } }
        if (cq == 7) p.out[O_PH + (size_t)b * LW + ch] = h; }
    __syncthreads();
    if (tid < 504) { const int ch8 = tid % 24, rg = tid / 24; const int chb = 192 * ns + 8 * ch8;
#pragma unroll 1
        for (int cc = (cq == 0 ? 1 : 0); cc < 4; ++cc) {
            const f32x4 ha = *(const LAS f32x4*)(HIN + cc * 192 + 8 * ch8), hb = *(const LAS f32x4*)(HIN + cc * 192 + 8 * ch8 + 4);
            const size_t tok0 = (size_t)b * SEQ + (4 * cq + cc) * TC;
            u32x4 gw_[4], cw_[4];
#pragma unroll
            for (int k = 0; k < 4; ++k) { const int r = rg + 21 * k; if (r < 64) { gw_[k] = __builtin_nontemporal_load((const u32x4*)(P + (tok0 + r) * PLD + PC_GA + chb)); cw_[k] = __builtin_nontemporal_load((const u32x4*)(CG + (tok0 + r) * LW + chb)); } }
#pragma unroll
            for (int k = 0; k < 4; ++k) { const int r = rg + 21 * k; if (r < 64) { float g[8], cgv[8]; unpack8(gw_[k], g); unpack8(cw_[k], cgv);
                g[0] += cgv[0] * ha[0]; g[1] += cgv[1] * ha[1]; g[2] += cgv[2] * ha[2]; g[3] += cgv[3] * ha[3]; g[4] += cgv[4] * hb[0]; g[5] += cgv[5] * hb[1]; g[6] += cgv[6] * hb[2]; g[7] += cgv[7] * hb[3];
                *(u32x4*)(P + (tok0 + r) * PLD + PC_GA + chb) = pack8(g); } }
        }
    }
}
__device__ __forceinline__ void sconv_prompt_unit(const Params& p, bf16_t* P, int unit, bool st = true) {
    const int tid = threadIdx.x; if (tid >= 384) return;
    const int ch8 = tid % 96, tg = tid / 96; const int tokg = unit * 64 + tg * 16; const int b = tokg >> 11, t0 = tokg & (SEQ - 1);
    const float* sw = p.in[I_SCW] + 8 * ch8; float w[3][8];
#pragma unroll
    for (int k = 0; k < 3; ++k) { const f32x4 a = *(const f32x4*)(sw + k * LW), bb = *(const f32x4*)(sw + k * LW + 4); w[k][0] = a[0]; w[k][1] = a[1]; w[k][2] = a[2]; w[k][3] = a[3]; w[k][4] = bb[0]; w[k][5] = bb[1]; w[k][6] = bb[2]; w[k][7] = bb[3]; }
    float c2[8], c1[8];
#pragma unroll
    for (int j = 0; j < 8; ++j) { c2[j] = 0.f; c1[j] = 0.f; }
    if (t0 >= 2) { unpack8(*(const u32x4*)(P + (size_t)(tokg - 2) * PLD + PC_CIN + 8 * ch8), c2); unpack8(*(const u32x4*)(P + (size_t)(tokg - 1) * PLD + PC_CIN + 8 * ch8), c1); }
#pragma unroll 1
    for (int i0 = 0; i0 < 16; i0 += 8) {
        u32x4 cw_[8], gw_[8];
#pragma unroll
        for (int i = 0; i < 8; ++i) { const bf16_t* prow = P + (size_t)(tokg + i0 + i) * PLD; cw_[i] = *(const u32x4*)(prow + PC_CIN + 8 * ch8); gw_[i] = *(const u32x4*)(prow + PC_GB + 8 * ch8); }
#pragma unroll
        for (int i = 0; i < 8; ++i) { bf16_t* prow = P + (size_t)(tokg + i0 + i) * PLD; float c0[8], g[8]; unpack8(cw_[i], c0); unpack8(gw_[i], g);
#pragma unroll
            for (int j = 0; j < 8; ++j) g[j] *= (w[0][j] * c2[j] + w[1][j] * c1[j] + w[2][j] * c0[j]);
            if (st) *(u32x4*)(prow + PC_GB + 8 * ch8) = pack8(g);
            if (t0 + i0 + i >= SEQ - 2) { float* o = p.out + O_PSC + ((size_t)b * 2 + (t0 + i0 + i - (SEQ - 2))) * LW + 8 * ch8; *(f32x4*)o = (f32x4){c0[0], c0[1], c0[2], c0[3]}; *(f32x4*)(o + 4) = (f32x4){c0[4], c0[5], c0[6], c0[7]}; }
#pragma unroll
            for (int j = 0; j < 8; ++j) { c2[j] = c1[j]; c1[j] = c0[j]; } }
    }
}
__device__ __forceinline__ void sconv_fix(const Params& p, bf16_t* P, int bx, int G) {
    const int tid = threadIdx.x;
    const int bxs = (G >= 192) ? bx - 96 : bx;
    if (bxs < 0) return;
    for (int i = bxs * 512 + tid; i < 64 * 4 * 2 * 96; i += G * 512) { const int ch8 = i % 96, ri = i / 96; const int j = ri & 1, g = (ri >> 1) & 3, pm = ri >> 3;
        const int row = 256 * pm + 64 * g + j, t = row & (SEQ - 1);
        const float* sw = p.in[I_SCW] + 8 * ch8; bf16_t* prow = P + (size_t)row * PLD;
        float c0[8], c1[8], c2[8], gv[8];
        unpack8(*(const u32x4*)(prow + PC_CIN + 8 * ch8), c0); unpack8(*(const u32x4*)(prow + PC_GB + 8 * ch8), gv);
#pragma unroll
        for (int k = 0; k < 8; ++k) { c1[k] = 0.f; c2[k] = 0.f; }
        if (t >= 1) unpack8(*(const u32x4*)(prow - PLD + PC_CIN + 8 * ch8), c1);
        if (t >= 2) unpack8(*(const u32x4*)(prow - 2 * PLD + PC_CIN + 8 * ch8), c2);
#pragma unroll
        for (int hh = 0; hh < 2; ++hh) { const f32x4 w0 = *(const f32x4*)(sw + 4 * hh), w1 = *(const f32x4*)(sw + LW + 4 * hh), w2 = *(const f32x4*)(sw + 2 * LW + 4 * hh);
#pragma unroll
            for (int k = 0; k < 4; ++k) gv[4 * hh + k] *= (w0[k] * c2[4 * hh + k] + w1[k] * c1[4 * hh + k] + w2[k] * c0[4 * hh + k]); }
        *(u32x4*)(prow + PC_GB + 8 * ch8) = pack8(gv); }
    for (int i = bxs * 512 + tid; i < NB * 2 * 96; i += G * 512) { const int ch8 = i % 96, ri = i / 96; const int k = ri & 1, b = ri >> 1;
        float c0[8]; unpack8(*(const u32x4*)(P + ((size_t)b * SEQ + SEQ - 2 + k) * PLD + PC_CIN + 8 * ch8), c0);
        float* o = p.out + O_PSC + ((size_t)b * 2 + k) * LW + 8 * ch8; *(f32x4*)o = (f32x4){c0[0], c0[1], c0[2], c0[3]}; *(f32x4*)(o + 4) = (f32x4){c0[4], c0[5], c0[6], c0[7]}; }
}
__device__ __forceinline__ void sconv_sample_unit(const Params& p, bf16_t* P, int unit) {
    for (int idx = threadIdx.x; idx < 32 * 96; idx += 512) { const int smp = unit * 32 + idx / 96, ch8 = idx % 96;
        const float* sw = p.in[I_SCW] + 8 * ch8; const float* st = p.in[I_SSC] + (size_t)smp * 2 * LW + 8 * ch8; float* so = p.out + O_SSC + (size_t)smp * 2 * LW + 8 * ch8;
        bf16_t* prow = P + (size_t)(MP + smp) * PLD; float c0[8], g[8]; unpack8(*(const u32x4*)(prow + PC_CIN + 8 * ch8), c0); unpack8(*(const u32x4*)(prow + PC_GB + 8 * ch8), g);
#pragma unroll
        for (int hh = 0; hh < 2; ++hh) { const f32x4 b0 = *(const f32x4*)(st + 4 * hh), b1 = *(const f32x4*)(st + LW + 4 * hh), w0 = *(const f32x4*)(sw + 4 * hh), w1 = *(const f32x4*)(sw + LW + 4 * hh), w2 = *(const f32x4*)(sw + 2 * LW + 4 * hh);
#pragma unroll
            for (int j = 0; j < 4; ++j) g[4 * hh + j] *= (w0[j] * b0[j] + w1[j] * b1[j] + w2[j] * c0[4 * hh + j]);
            *(f32x4*)(so + 4 * hh) = b1; *(f32x4*)(so + LW + 4 * hh) = (f32x4){c0[4 * hh], c0[4 * hh + 1], c0[4 * hh + 2], c0[4 * hh + 3]}; }
        *(u32x4*)(prow + PC_GB + 8 * ch8) = pack8(g); }
}

__device__ __forceinline__ void sample_g2(LAS unsigned char* lds, bf16_t* P, const bf16_t* WcatT, int bx, int G) {
    const int tid = threadIdx.x, lane = tid & 63, wave = tid >> 6, ti = wave >> 2, role = wave & 3, col = lane & 15, quad = lane >> 4;
    LAS float* red = (LAS float*)lds;
    for (int base = 2 * bx; base < 512; base += 2 * G) {
        const int id = base + ti, mt = id & 7, nt16 = id >> 3;
        __syncthreads();
        if (role < 3) {
            const int koff = 768 * role, nks = role < 2 ? 24 : 16;
            const bf16_t* ap = P + (size_t)(MP + 16 * mt + col) * PLD + koff + 8 * quad;
            const bf16_t* bp = WcatT + (size_t)(16 * nt16 + col) * 2048 + koff + 8 * quad;
            f32x4 acc = (f32x4){0.f, 0.f, 0.f, 0.f};
#pragma unroll 8
            for (int ks = 0; ks < nks; ++ks) { const bf16x8 a = *(const bf16x8*)(ap + 32 * ks), b = *(const bf16x8*)(bp + 32 * ks); acc = __builtin_amdgcn_mfma_f32_16x16x32_bf16(a, b, acc, 0, 0, 0); }
#pragma unroll
            for (int r = 0; r < 4; ++r) acc[r] *= bf2f(P[(size_t)(MP + 16 * mt + 4 * quad + r) * PLD + PC_G + 1024 * role + 16 * nt16 + col]);
            *(LAS f32x4*)(red + ((ti * 3 + role) * 64 + lane) * 4) = acc;
        }
        __syncthreads();
        if (role == 0) {
            const f32x4 v = *(const LAS f32x4*)(red + ((ti * 3 + 0) * 64 + lane) * 4) + *(const LAS f32x4*)(red + ((ti * 3 + 1) * 64 + lane) * 4) + *(const LAS f32x4*)(red + ((ti * 3 + 2) * 64 + lane) * 4);
#pragma unroll
            for (int r = 0; r < 4; ++r) P[(size_t)(MP + 16 * mt + 4 * quad + r) * PLD + PC_MRG + 16 * nt16 + col] = (bf16_t)(cvt_pk_bf16(v[r], 0.f) & 0xffffu);
        }
    }
}
__device__ __forceinline__ void sample_g3(LAS unsigned char* lds, const bf16_t* P, const bf16_t* WoutT, const float* xs, float* out, float* rss2, int bx, int G) {
    const int tid = threadIdx.x, lane = tid & 63, wave = tid >> 6, ti = wave >> 2, role = wave & 3, col = lane & 15, quad = lane >> 4;
    LAS float* red = (LAS float*)lds;
    for (int base = 2 * bx; base < 512; base += 2 * G) {
        const int id = base + ti, mt = id & 7, nt16 = id >> 3;
        __syncthreads();
        {
            const bf16_t* ap = P + (size_t)(MP + 16 * mt + col) * PLD + PC_MRG + 256 * role + 8 * quad;
            const bf16_t* bp = WoutT + (size_t)(16 * nt16 + col) * D + 256 * role + 8 * quad;
            f32x4 acc = (f32x4){0.f, 0.f, 0.f, 0.f};
#pragma unroll
            for (int ks = 0; ks < 8; ++ks) { const bf16x8 a = *(const bf16x8*)(ap + 32 * ks), b = *(const bf16x8*)(bp + 32 * ks); acc = __builtin_amdgcn_mfma_f32_16x16x32_bf16(a, b, acc, 0, 0, 0); }
            *(LAS f32x4*)(red + ((ti * 4 + role) * 64 + lane) * 4) = acc;
        }
        __syncthreads();
        if (role == 0) {
            const f32x4 v = (*(const LAS f32x4*)(red + ((ti * 4 + 0) * 64 + lane) * 4) + *(const LAS f32x4*)(red + ((ti * 4 + 1) * 64 + lane) * 4)) + (*(const LAS f32x4*)(red + ((ti * 4 + 2) * 64 + lane) * 4) + *(const LAS f32x4*)(red + ((ti * 4 + 3) * 64 + lane) * 4));
#pragma unroll
            for (int r = 0; r < 4; ++r) { const int m = 16 * mt + 4 * quad + r, n = 16 * nt16 + col; const float xo = xs[(size_t)m * D + n] + v[r]; out[(size_t)(MP + m) * D + n] = xo;
                float ss = xo * xo; ss += __shfl_xor(ss, 1); ss += __shfl_xor(ss, 2); ss += __shfl_xor(ss, 4); ss += __shfl_xor(ss, 8);
                if (col == 0) rss2[m * 64 + nt16] = ss; }
        }
    }
}

__global__ void __launch_bounds__(512, 2) fwd_kernel(Params p) {
    extern __shared__ __attribute__((aligned(16))) unsigned char lds_raw[];
    LAS unsigned char* lds = (LAS unsigned char*)lds_raw;
    volatile LAS unsigned* MISC = (volatile LAS unsigned*)(lds + 131072 + 8192);
    const int tid = threadIdx.x, G = gridDim.x, bx = blockIdx.x;
    const int vcu = (G % 8 == 0) ? (bx % 8) * (G / 8) + bx / 8 : bx;
    if (tid < 64) MISC[tid] = 0u;
    __syncthreads();
    const int lo = p.ph_lo, hi = p.ph_hi;
    const bool multi = (hi - lo) > 1;
    XcdBarrier bar; bar.bar = (unsigned*)(p.ws + WS_CTL); bar.x = 0; bar.st = nullptr;
    if (multi) bar = xcd_barrier_post((unsigned*)(p.ws + WS_CTL), MISC + 8);
#ifndef PHASE_MASK
#define PHASE_MASK 0x7f
#endif
#ifndef UNIT_MASK
#define UNIT_MASK 0x3f
#endif
#define IN(k) ((((PHASE_MASK) >> (k)) & 1) && lo <= (k) && (k) < hi)
#define SEAM(k) do { if (IN(k) && IN((k) + 1)) xcd_barrier(bar); } while (0)
    bf16_t* P = (bf16_t*)(p.ws + WS_P);
    bf16_t* U = (bf16_t*)((unsigned char*)p.out + DO_U); bf16_t* WinT = (bf16_t*)((unsigned char*)p.out + DO_WIN);
    bf16_t* WcatT = (bf16_t*)(p.ws + WS_WCAT); bf16_t* WoutT = (bf16_t*)(p.ws + WS_WOUT); bf16_t* WgT = (bf16_t*)(p.ws + WS_WG);
    bf16_t* KB = (bf16_t*)(p.ws + WS_KB); bf16_t* VtB = (bf16_t*)(p.ws + WS_VT); float* agg = (float*)(p.ws + WS_AGG); bf16_t* CG = (bf16_t*)((unsigned char*)p.out + DO_U); float* rss = (float*)(p.ws + WS_RSS); float* rss2 = rss + (size_t)MPAD * 16;

#ifndef DUP_MASK
#define DUP_MASK 0
#endif
    const int nfull = (65 * 34 + 32) % G;
    const bool defer = (nfull != 0) && (G - nfull >= 32);
    if (IN(0)) { p0_prologue(p, lds, vcu * 8 + (tid >> 6), G * 8, 0); if (!defer) p0_prologue(p, lds, vcu * 8 + (tid >> 6), G * 8, 1); }
    SEAM(0);
    if (IN(1)) {
        pg8::Gemm g{U, WinT, D, D}; Sched1 S{G, bx}; Epi1 E{P, p.out + O_PMK, p.out + O_PMV, KB, VtB, p.in[I_SCW]};
        pg8::gemm_phase<Epi1, Sched1>(lds, g, S, E);
        if (defer && bx >= nfull) p0_prologue(p, lds, (bx - nfull) * 8 + (tid >> 6), (G - nfull) * 8, 1);
    }
    SEAM(1);
    if (IN(2)) {
        const bool nost = (p.ph_lo != 0);
        if (DUP_MASK & 0x100) for (int u = bx; u < 256; u += G) attn_prompt_unit(lds, P, KB, VtB, u, nost);
        if (DUP_MASK & 0x200) for (int u = bx; u < 512; u += G) attn_sample_unit(lds, P, p.in[I_CK], p.in[I_CV], u, nost);
        if (DUP_MASK & 0x800) for (int u = bx; u < 256; u += G) sconv_prompt_unit(p, P, u, nost);
        if (UNIT_MASK & 1) for (int u = bx; u < 256; u += G) attn_prompt_unit(lds, P, KB, VtB, u);
        if (UNIT_MASK & 2) attn_sample_phase(lds, P, p.in[I_CK], p.in[I_CV], bx, 512, G);
        if (UNIT_MASK & 4) lru_phase<0>(lds, p, P, WgT, agg, CG, bx, NB * NCH * NLB, G);
        if (UNIT_MASK & 8) lru_phase<2>(lds, p, P, WgT, agg, CG, G - 1 - bx, 24, G);
        if (UNIT_MASK & 16) sconv_fix(p, P, bx, G);
        if (UNIT_MASK & 32) for (int u = bx - 32; u >= 0 && u < 4; u += G) sconv_sample_unit(p, P, u);
    }
    SEAM(2);
    if (IN(3)) {
        sample_g2(lds, P, WcatT, bx, G);
        for (int u = bx; u < 256; u += G) lru_fix_item(lds, p, P, CG, agg, u);
    }
    SEAM(3);
    if (IN(4)) {
        { pg8::Gemm g{P, WcatT, PLD, 2048}; Sched2 S{G, vcu, 0, 256}; Epi2 E{P}; pg8::gemm_phase<Epi2, Sched2>(lds, g, S, E); if (DUP_MASK & 16) pg8::gemm_phase<Epi2, Sched2>(lds, g, S, E); }
        sample_g3(lds, P, WoutT, p.in[I_XS], p.out, rss2, bx, G);
    }
    SEAM(4);
    const bool fused_norm = (G == 256);
    if (IN(5)) {
        pg8::Gemm g{P, WoutT, PLD, D}; Sched3 S{G, vcu, 0, 256};
        if (fused_norm) { Epi3F E{p.in[I_XP], p.out, p.in[I_FNG], (float*)(p.ws + WS_CTL + 65536), (unsigned*)(p.ws + WS_CTL) + 4096, lds}; pg8::gemm_phase<Epi3F, Sched3>(lds, g, S, E); }
        else { Epi3 E{p.in[I_XP], p.in[I_XS], p.out, rss}; pg8::gemm_phase<Epi3, Sched3>(lds, g, S, E); }
    }
    if (!fused_norm) SEAM(5);
    if (IN(6)) {
        const int lane = tid & 63, wave = tid >> 6; const float* fg = p.in[I_FNG];
        for (int m = (fused_norm ? MP : 0) + vcu * 8 + wave; m < MT; m += G * 8) {
            float ss;
            if (m < MP) { const f32x4* rs = (const f32x4*)(rss + (size_t)m * 16); const f32x4 a = rs[0], b2 = rs[1], c2 = rs[2], d2 = rs[3];
                ss = ((a[0] + a[1]) + (a[2] + a[3])) + ((b2[0] + b2[1]) + (b2[2] + b2[3])) + ((c2[0] + c2[1]) + (c2[2] + c2[3])) + ((d2[0] + d2[1]) + (d2[2] + d2[3])); }
            else ss = wave_sum(rss2[(m - MP) * 64 + lane]);
            const float rstd = 1.f / sqrtf(ss * (1.f / D) + EPS);
            f32x4* row = (f32x4*)(p.out + (size_t)m * D) + lane; const f32x4* gr = (const f32x4*)fg + lane;
#pragma unroll
            for (int j = 0; j < 4; ++j) { const f32x4 v = row[64 * j], gg = gr[64 * j]; row[64 * j] = v * rstd * gg; }
        }
    }
#undef IN
#undef SEAM
}

#ifndef MK_N_LAUNCHES
#define MK_N_LAUNCHES 1
#endif
extern "C" void kernel_launch(void* const* d_in, const int* in_sizes, int n_in, void* d_out, int out_size, void* d_ws, size_t ws_size, hipStream_t stream) {
    static int grid = 0;
    if (grid == 0) {
        if (n_in != 26 || out_size != (int)O_END || ws_size < WS_END) { fprintf(stderr, "kernel_launch: unexpected shapes (n_in %d, out %d, ws %zu)\n", n_in, out_size, ws_size); grid = -1; return; }
        int dev = 0, cus = 0, per_cu = 0;
        hipGetDevice(&dev); hipDeviceGetAttribute(&cus, hipDeviceAttributeMultiprocessorCount, dev);
        if (hipFuncSetAttribute((const void*)fwd_kernel, hipFuncAttributeMaxDynamicSharedMemorySize, LDS_BYTES) != hipSuccess) { fprintf(stderr, "kernel_launch: hipFuncSetAttribute failed\n"); grid = -1; return; }
        hipOccupancyMaxActiveBlocksPerMultiprocessor(&per_cu, (const void*)fwd_kernel, 512, LDS_BYTES);
        (void)hipGetLastError();
        if (per_cu < 1) fprintf(stderr, "kernel_launch: occupancy query says %d blocks per CU\n", per_cu);
        grid = cus;
    }
    if (grid < 0) return;
    (void)hipMemsetAsync((char*)d_ws + WS_CTL, 0, 32768, stream);
    Params p{};
    for (int i = 0; i < 26; ++i) p.in[i] = (const float*)d_in[i];
    p.out = (float*)d_out; p.ws = (unsigned char*)d_ws;
#if MK_N_LAUNCHES == 1
    p.ph_lo = 0; p.ph_hi = 7;
    void* args[] = {&p};
    hipError_t e = hipLaunchCooperativeKernel((const void*)fwd_kernel, dim3(grid), dim3(512), args, LDS_BYTES, stream);
    if (e != hipSuccess) fprintf(stderr, "cooperative launch failed: %s (grid %d)\n", hipGetErrorString(e), grid);
#else
    for (int k = 0; k < 7; ++k) { p.ph_lo = k; p.ph_hi = k + 1; hipLaunchKernelGGL(fwd_kernel, dim3(grid), dim3(512), LDS_BYTES, stream, p); }
#endif
}
```

```cpp
#include <hip/hip_runtime.h>
#include <cstdio>
#include <cstdint>

#define LAS __attribute__((address_space(3)))
typedef unsigned short bf16_t;
typedef short bf16x8 __attribute__((ext_vector_type(8)));
typedef float f32x4 __attribute__((ext_vector_type(4)));
typedef float f32x16 __attribute__((ext_vector_type(16)));
typedef unsigned u32x4 __attribute__((ext_vector_type(4)));
typedef unsigned u32x2 __attribute__((ext_vector_type(2)));

constexpr int D = 1024, NB = 8, SEQ = 2048, MP = NB * SEQ, NS = 128, MT = MP + NS, MPAD = 16640;
constexpr int NMEM = 256, MEMROWS = NB * NMEM, UROWS = MPAD + MEMROWS;
constexpr int LW = 768, NLB = 6, LBW = 128, XH = 4, XD = 128, XW = 512, INC = 8704;
constexpr float EPS = 1e-6f;
constexpr int PC_GA = 0, PC_GB = 768, PC_GC = 1536, PC_LX = 2048, PC_CIN = 2816, PC_Q = 3584, PC_G = 4096, PLD = 7168, PC_MRG = 2048;
constexpr int TC = 64, NCH = SEQ / TC;
constexpr size_t O_Y = 0, O_PMK = (size_t)MT * D, O_PMV = O_PMK + (size_t)MEMROWS * XW, O_PH = O_PMV + (size_t)MEMROWS * XW,
                 O_PLC = O_PH + NB * LW, O_PSC = O_PLC + NB * 3 * LW, O_SH = O_PSC + NB * 2 * LW, O_SLC = O_SH + NS * LW, O_SSC = O_SLC + NS * 3 * LW,
                 O_END = O_SSC + NS * 2 * LW;
constexpr size_t MiB = 1u << 20;
constexpr size_t WS_P = 0, WS_WCAT = 228 * MiB, WS_WOUT = 232 * MiB, WS_WG = 234 * MiB, WS_KB = 235 * MiB, WS_VT = 237 * MiB, WS_AGG = 239 * MiB,
                 WS_RSS = 241 * MiB, WS_CTL = 244 * MiB, WS_END = 245 * MiB;
static_assert((size_t)MPAD * PLD * 2 <= WS_WCAT, "P fits");
constexpr size_t DO_U = 0, DO_WIN = 40 * MiB;
static_assert((size_t)UROWS * D * 2 <= DO_WIN && DO_WIN + (size_t)9728 * D * 2 <= (size_t)MP * D * 4, "d_out scratch fits under y_prompt");
constexpr int LDS_BYTES = 147456;

typedef float f32x2_t __attribute__((ext_vector_type(2))); typedef __bf16 bf16x2_t __attribute__((ext_vector_type(2)));
__device__ __forceinline__ unsigned cvt_pk_bf16(float lo, float hi) { const f32x2_t v = {lo, hi}; const bf16x2_t b = __builtin_convertvector(v, bf16x2_t); return __builtin_bit_cast(unsigned, b); }
__device__ __forceinline__ float bflo(unsigned w) { return __uint_as_float(w << 16); }
__device__ __forceinline__ float bfhi(unsigned w) { return __uint_as_float(w & 0xffff0000u); }
__device__ __forceinline__ float bf2f(bf16_t v) { return __uint_as_float(((unsigned)v) << 16); }
__device__ __forceinline__ float sigm(float x) { return __builtin_amdgcn_rcpf(1.f + __expf(-x)); }
__device__ __forceinline__ float silu(float x) { return x * sigm(x); }
__device__ __forceinline__ float wave_sum(float v) {
#pragma unroll
    for (int o = 1; o < 64; o <<= 1) v += __shfl_xor(v, o);
    return v;
}
__device__ __forceinline__ float wave_max(float v) {
#pragma unroll
    for (int o = 1; o < 64; o <<= 1) v = fmaxf(v, __shfl_xor(v, o));
    return v;
}
__device__ __forceinline__ void unpack8(const u32x4 w, float* f) {
    f[0] = bflo(w.x); f[1] = bfhi(w.x); f[2] = bflo(w.y); f[3] = bfhi(w.y); f[4] = bflo(w.z); f[5] = bfhi(w.z); f[6] = bflo(w.w); f[7] = bfhi(w.w);
}
__device__ __forceinline__ u32x4 pack8(const float* f) {
    u32x4 w; w.x = cvt_pk_bf16(f[0], f[1]); w.y = cvt_pk_bf16(f[2], f[3]); w.z = cvt_pk_bf16(f[4], f[5]); w.w = cvt_pk_bf16(f[6], f[7]); return w;
}

namespace pg8 {
constexpr int BM = 256, BK = 64, HALF = 128, HTB = HALF * BK * 2, STAGE_BYTES = 8 * HTB, NXCD = 8, WGM = 8;
__host__ __device__ __forceinline__ int lds_byte(int r, int c) { const int st = (r >> 4) * 2 + (c >> 5), rr = r & 15, cc = c & 31, ob = rr * 64 + cc * 2; return st * 1024 + (ob ^ (((ob >> 9) & 1) << 5)); }
__host__ __device__ __forceinline__ void stage_rc(int b, int& R, int& C) { const int st = b / 1024, sb = b % 1024, swz = sb ^ (((sb >> 9) & 1) << 5); R = (st >> 1) * 16 + swz / 64; C = (st & 1) * 32 + (swz % 64) / 2; }
__host__ __device__ __forceinline__ int perm32(int rho) { const int n = rho >> 4, i = rho & 15; return 8 * (i >> 2) + 4 * n + (i & 3); }

struct Unit { int pm, pn, seg; };
struct Gemm { const bf16_t* A; const bf16_t* Bt; int lda, ldb; };

template <class Epi, class Sched>
__device__ __forceinline__ void gemm_phase(LAS unsigned char* lds, const Gemm g, const Sched& S, const Epi& E) {
    const int tid = threadIdx.x, wid = __builtin_amdgcn_readfirstlane(tid >> 6), lane = tid & 63, wr = wid >> 2, wc = wid & 3, fr = lane & 15, fq = lane >> 4;
    unsigned voffA[2], voffB[2];
#pragma unroll
    for (int i = 0; i < 2; ++i) { int R, C; stage_rc(tid * 16 + i * 8192, R, C); const int Rb = Epi::PERM ? ((R & ~31) + perm32(R & 31)) : R;
        voffA[i] = (unsigned)(R * g.lda + C) * 2u; voffB[i] = (unsigned)(Rb * g.ldb + C) * 2u; }
    const size_t kstep = (size_t)(BK * 2);
    const size_t hstepA = (size_t)HALF * g.lda * 2, hstepB = (size_t)HALF * g.ldb * 2;
    const unsigned ldsw = (unsigned)wid * 1024u;
    const int aoff = lds_byte(wr * 64 + fr, fq * 8), boff = lds_byte(wc * 32 + fr, fq * 8);
#define PG8_SA(b, h) (((b) * 2 + (h)) * HTB)
#define PG8_SB(b, h) ((4 + (b) * 2 + (h)) * HTB)
#define PG8_STAGE(bufoff, gbase, voff) do { _Pragma("unroll") for (int _i = 0; _i < 2; ++_i) \
        __builtin_amdgcn_global_load_lds((const unsigned*)((const char*)(gbase) + (voff)[_i]), (LAS unsigned*)(lds + (bufoff) + ldsw + _i * 8192), 16, 0, 0); } while (0)
#define PG8_LDA(dst, b, h) do { _Pragma("unroll") for (int m = 0; m < 4; ++m) _Pragma("unroll") for (int k = 0; k < 2; ++k) dst[m][k] = *(const LAS bf16x8*)(lds + PG8_SA(b, h) + aoff + m * 2048 + k * 1024); } while (0)
#define PG8_LDB(dst, b, h) do { _Pragma("unroll") for (int n = 0; n < 2; ++n) _Pragma("unroll") for (int k = 0; k < 2; ++k) dst[n][k] = *(const LAS bf16x8*)(lds + PG8_SB(b, h) + boff + n * 2048 + k * 1024); } while (0)
#define PG8_MMA(ai, bj, At, Bt) do { __builtin_amdgcn_s_setprio(1); _Pragma("unroll") for (int m = 0; m < 4; ++m) _Pragma("unroll") for (int n = 0; n < 2; ++n) _Pragma("unroll") for (int k = 0; k < 2; ++k) \
        acc[ai][bj][m][n] = __builtin_amdgcn_mfma_f32_16x16x32_bf16(Bt[n][k], At[m][k], acc[ai][bj][m][n], 0, 0, 0); __builtin_amdgcn_s_setprio(0); } while (0)
#define PG8_WAIT_V(n) asm volatile("s_waitcnt vmcnt(" #n ")" ::: "memory")
#define PG8_WAIT_L(n) asm volatile("s_waitcnt lgkmcnt(" #n ")" ::: "memory")
#define PG8_BAR __builtin_amdgcn_s_barrier()
#define PG8_SCHED __builtin_amdgcn_sched_barrier(0)
    Unit cur, nxt; int ui = 0;
    if (!S.next(0, cur)) return;
    f32x4 acc[2][2][4][2];
#pragma unroll
    for (int a = 0; a < 2; ++a)
#pragma unroll
        for (int b = 0; b < 2; ++b)
#pragma unroll
            for (int m = 0; m < 4; ++m)
#pragma unroll
                for (int n = 0; n < 2; ++n) acc[a][b][m][n] = (f32x4){0.f, 0.f, 0.f, 0.f};
    bf16x8 At[4][2], B0[2][2], B1[2][2];
    const char* cA = (const char*)g.A + S.a_off(cur); const char* cB = (const char*)g.Bt + S.b_off(cur);
    int nt = S.nt(cur);
    PG8_STAGE(PG8_SB(0, 0), cB, voffB); PG8_STAGE(PG8_SB(0, 1), cB + hstepB, voffB); PG8_STAGE(PG8_SA(0, 0), cA, voffA); PG8_STAGE(PG8_SA(0, 1), cA + hstepA, voffA);
    if (wr == 1) PG8_BAR;
    PG8_WAIT_V(2); PG8_BAR;
    PG8_STAGE(PG8_SB(1, 0), cB + kstep, voffB); PG8_STAGE(PG8_SA(1, 0), cA + kstep, voffA); PG8_STAGE(PG8_SB(1, 1), cB + hstepB + kstep, voffB);
    PG8_WAIT_V(6); PG8_BAR;
    for (;;) {
        const bool has_next = S.next(ui + 1, nxt);
        const char* nA = has_next ? (const char*)g.A + S.a_off(nxt) : cA; const char* nB = has_next ? (const char*)g.Bt + S.b_off(nxt) : cB;
        for (int t = 0; t < nt; t += 2) {
            const bool last = (t == nt - 2);
            const char* a1 = cA + (size_t)(t + 1) * kstep;
            const char* a2 = last ? nA : cA + (size_t)(t + 2) * kstep; const char* b2 = last ? nB : cB + (size_t)(t + 2) * kstep;
            const char* a3 = a2 + kstep; const char* b3 = b2 + kstep;
            PG8_LDB(B0, 0, 0); PG8_LDB(B1, 0, 1); PG8_SCHED; PG8_LDA(At, 0, 0); PG8_STAGE(PG8_SA(1, 1), a1 + hstepA, voffA);
            PG8_WAIT_V(8); PG8_WAIT_L(0); PG8_BAR; PG8_MMA(0, 0, At, B0); PG8_MMA(0, 1, At, B1); PG8_BAR; PG8_SCHED;
            PG8_LDA(At, 0, 1); PG8_STAGE(PG8_SB(0, 0), b2, voffB); PG8_STAGE(PG8_SB(0, 1), b2 + hstepB, voffB); PG8_STAGE(PG8_SA(0, 0), a2, voffA);
            PG8_WAIT_V(8); PG8_WAIT_L(0); PG8_BAR; PG8_MMA(1, 0, At, B0); PG8_MMA(1, 1, At, B1); PG8_BAR; PG8_SCHED;
            PG8_LDB(B0, 1, 0); PG8_LDB(B1, 1, 1); PG8_SCHED; PG8_LDA(At, 1, 0); PG8_STAGE(PG8_SA(0, 1), a2 + hstepA, voffA);
            PG8_WAIT_V(8); PG8_WAIT_L(0); PG8_BAR; PG8_MMA(0, 0, At, B0); PG8_MMA(0, 1, At, B1); PG8_BAR; PG8_SCHED;
            PG8_LDA(At, 1, 1); PG8_STAGE(PG8_SB(1, 0), b3, voffB); PG8_STAGE(PG8_SB(1, 1), b3 + hstepB, voffB); PG8_STAGE(PG8_SA(1, 0), a3, voffA);
            PG8_WAIT_V(8); PG8_WAIT_L(0); PG8_BAR; PG8_MMA(1, 0, At, B0); PG8_MMA(1, 1, At, B1); PG8_BAR; PG8_SCHED;
        }
        if (wr == 0) PG8_BAR;
        const bool keep = E(acc, cur, wr, wc, fr, fq);
        if (!has_next) break;
        if (!keep) {
#pragma unroll
            for (int a = 0; a < 2; ++a)
#pragma unroll
                for (int b = 0; b < 2; ++b)
#pragma unroll
                    for (int m = 0; m < 4; ++m)
#pragma unroll
                        for (int n = 0; n < 2; ++n) acc[a][b][m][n] = (f32x4){0.f, 0.f, 0.f, 0.f};
        }
        cur = nxt; cA = nA; cB = nB; nt = S.nt(cur); ++ui;
        if (wr == 1) PG8_BAR;
    }
    PG8_WAIT_V(0);
    PG8_BAR;
#undef PG8_SA
#undef PG8_SB
#undef PG8_STAGE
#undef PG8_LDA
#undef PG8_LDB
#undef PG8_MMA
#undef PG8_WAIT_V
#undef PG8_WAIT_L
#undef PG8_BAR
#undef PG8_SCHED
}
}
using pg8::Unit;

#define XB_TMO      128
#define XB_XCNT(j)  (256  + 64 * (j))
#define XB_XSUB(j)  (1280 + 64 * (j))
#define XB_XGEN(j)  (2304 + 64 * (j))
#define XB_TOP      3328
#define XB_TOPGEN   3392
#define XCD_BAR_WORDS 3456
#define XB_SPIN_CAP (1u << 18)
__device__ __forceinline__ unsigned xb_ld(unsigned* p)              { return __hip_atomic_load(p, __ATOMIC_RELAXED, __HIP_MEMORY_SCOPE_AGENT); }
__device__ __forceinline__ unsigned xb_add(unsigned* p, unsigned v) { return __hip_atomic_fetch_add(p, v, __ATOMIC_RELAXED, __HIP_MEMORY_SCOPE_AGENT); }
__device__ __forceinline__ unsigned xb_xcc_id() { return (unsigned)__builtin_amdgcn_s_getreg((3 << 11) | 20) & 0xFu; }
#define XB_SPIN(cond, bar) do { unsigned _sp = 0; while (cond) { __builtin_amdgcn_s_sleep(1); \
    if ((++_sp & 255u) == 0u) { if (xb_ld(&(bar)[XB_TMO])) break; if (_sp > XB_SPIN_CAP) { atomicAdd(&(bar)[XB_TMO], 1u); break; } } } } while (0)
struct XcdBarrier { unsigned* bar; unsigned x; volatile LAS unsigned* st; };
__device__ __forceinline__ XcdBarrier xcd_barrier_post(unsigned* bar, volatile LAS unsigned* st) {
    XcdBarrier b; b.bar = bar; b.x = xb_xcc_id(); b.st = st;
    if (threadIdx.x == 0) (void)xb_add(&bar[XB_XCNT(b.x)], 1u);
    return b;
}
__device__ __forceinline__ void xcd_barrier_complete(unsigned* bar, unsigned x, unsigned& nloc, unsigned& nx) {
    const unsigned G = gridDim.x * gridDim.y * gridDim.z;
    unsigned sum, cnt, mine, sp = 0u;
    for (;;) {
        sum = 0u; cnt = 0u; mine = 0u;
#pragma unroll
        for (unsigned j = 0; j < 16; ++j) { const unsigned c = xb_ld(&bar[XB_XCNT(j)]); sum += c; cnt += (c > 0u) ? 1u : 0u; mine = (j == x) ? c : mine; }
        if (sum == G) break;
        __builtin_amdgcn_s_sleep(1);
        if ((++sp & 255u) == 0u) { if (xb_ld(&bar[XB_TMO])) break; if (sp > XB_SPIN_CAP) { atomicAdd(&bar[XB_TMO], 1u); break; } }
    }
    nloc = mine > 0u ? mine : 1u; nx = cnt > 0u ? cnt : 1u;
}
__device__ __forceinline__ void xcd_barrier(const XcdBarrier& b) {
    asm volatile("s_waitcnt vmcnt(0)" ::: "memory");
    __syncthreads();
    if (threadIdx.x == 0) {
        unsigned* bar = b.bar;
        __builtin_amdgcn_s_waitcnt(0);
        unsigned nloc = b.st[0], nx = b.st[1];
        if (nloc == 0u) { xcd_barrier_complete(bar, b.x, nloc, nx); b.st[0] = nloc; b.st[1] = nx; }
        const unsigned old = xb_add(&bar[XB_XSUB(b.x)], 1u);
        const unsigned gen = old / nloc;
        if (old + 1u == (gen + 1u) * nloc) {
            __builtin_amdgcn_fence(__ATOMIC_RELEASE, "agent");
            asm volatile("s_waitcnt vmcnt(0)" ::: "memory");
            const unsigned og = xb_add(&bar[XB_TOP], 1u);
            const unsigned tg = og / nx;
            if (og + 1u == (tg + 1u) * nx) xb_add(&bar[XB_TOPGEN], 1u);
            else XB_SPIN(xb_ld(&bar[XB_TOPGEN]) == tg, bar);
            __builtin_amdgcn_fence(__ATOMIC_ACQUIRE, "agent");
            xb_add(&bar[XB_XGEN(b.x)], 1u);
            asm volatile("s_waitcnt vmcnt(0)" ::: "memory");
        } else {
            XB_SPIN(xb_ld(&bar[XB_XGEN(b.x)]) == gen, bar);
            __builtin_amdgcn_fence(__ATOMIC_ACQUIRE, "agent");
            asm volatile("s_waitcnt vmcnt(0)" ::: "memory");
        }
    }
    __syncthreads();
}

struct Params { const float* in[26]; float* out; unsigned char* ws; int ph_lo, ph_hi; };
enum { I_XP = 0, I_XS, I_CK, I_CV, I_SH, I_SLC, I_SSC, I_MEM, I_NG, I_MNG, I_WIN, I_CW, I_CB, I_WA, I_BA, I_WX, I_BX, I_LAM, I_LWO, I_SCW, I_SWO, I_WK, I_WV, I_XWO, I_WOUT, I_FNG };

__device__ __forceinline__ int win_dst_row(int s) {
    if (s < 1536 || s >= 4608) { const int c = s & 255;
        return (s & ~255) + 128 * ((c >> 5) & 1) + 32 * (c >> 6) + (c & 31); }
    const int q = s - 1536, seg = q / 768, ch = q - seg * 768;
    return 1536 + 256 * (ch >> 6) + 128 * (seg >> 1) + 32 * ((ch & 63) >> 4) + 8 * ((ch & 15) >> 2) + 4 * (seg & 1) + (ch & 3);
}
template <int MAP>
__device__ __forceinline__ void transpose_item(const float* W, int ldw, int k0, int s0, bf16_t* WT, int ldo, int rowoff, int coloff, LAS float* scr, int lane) {
    { f32x4 v[8];
#pragma unroll
        for (int i = 0; i < 8; ++i) v[i] = __builtin_nontemporal_load((const f32x4*)(W + (size_t)(k0 + 8 * i + (lane >> 3)) * ldw + s0 + 4 * (lane & 7)));
#pragma unroll
        for (int i = 0; i < 8; ++i) { LAS float* d = scr + (8 * i + (lane >> 3)) * 33 + 4 * (lane & 7); d[0] = v[i][0]; d[1] = v[i][1]; d[2] = v[i][2]; d[3] = v[i][3]; } }
    asm volatile("s_waitcnt lgkmcnt(0)" ::: "memory");
    const int c = lane & 7;
#pragma unroll
    for (int j = 0; j < 4; ++j) { const int n = (lane >> 3) + 8 * j; const LAS float* s = scr + (8 * c) * 33 + n;
        u32x4 o; o.x = cvt_pk_bf16(s[0 * 33], s[1 * 33]); o.y = cvt_pk_bf16(s[2 * 33], s[3 * 33]); o.z = cvt_pk_bf16(s[4 * 33], s[5 * 33]); o.w = cvt_pk_bf16(s[6 * 33], s[7 * 33]);
        const int drow = MAP ? win_dst_row(s0 + n) : (rowoff + s0 + n);
        *(u32x4*)(WT + (size_t)drow * ldo + coloff + k0 + 8 * c) = o; }
    asm volatile("s_waitcnt lgkmcnt(0)" ::: "memory");
}
__device__ __forceinline__ void rms_row(const float* xrow, const float* g, bf16_t* orow, int lane) {
    const f32x4* xr = (const f32x4*)xrow + lane; const f32x4* gr = (const f32x4*)g + lane;
    f32x4 v[4]; float s = 0.f;
#pragma unroll
    for (int j = 0; j < 4; ++j) { v[j] = xr[64 * j]; s += (v[j].x * v[j].x + v[j].y * v[j].y) + (v[j].z * v[j].z + v[j].w * v[j].w); }
    const float rstd = 1.f / sqrtf(wave_sum(s) * (1.f / D) + EPS);
    u32x2* o8 = (u32x2*)orow + lane;
#pragma unroll
    for (int j = 0; j < 4; ++j) { const f32x4 gg = gr[64 * j]; u32x2 w; w.x = cvt_pk_bf16(v[j].x * rstd * gg.x, v[j].y * rstd * gg.y); w.y = cvt_pk_bf16(v[j].z * rstd * gg.z, v[j].w * rstd * gg.w); o8[64 * j] = w; }
}
__device__ __forceinline__ void p0_prologue(const Params& p, LAS unsigned char* lds, int gw, int NGW, int part) {
    const int tid = threadIdx.x, lane = tid & 63, wave = tid >> 6;
    LAS float* scr = (LAS float*)(lds + wave * 16384);
    bf16_t* WinT = (bf16_t*)((unsigned char*)p.out + DO_WIN); bf16_t* U = (bf16_t*)((unsigned char*)p.out + DO_U);
    bf16_t* WcatT = (bf16_t*)(p.ws + WS_WCAT); bf16_t* WoutT = (bf16_t*)(p.ws + WS_WOUT); bf16_t* WgT = (bf16_t*)(p.ws + WS_WG);
    constexpr int N0 = 16 * 272, N1 = 16 * 16, N3 = 12 * 32, N5 = 8 * 32, N6 = 16 * 32, N7 = 6 * 8;
    constexpr int NITEMS = N0 + 2 * N1 + 2 * N3 + N5 + N6 + 2 * N7, NSPLIT = N0 + 2 * N1;
    for (int it = (part ? NSPLIT : 0) + (NGW - 1 - gw); it < (part ? NITEMS : NSPLIT); it += NGW) {
        int r = it;
        if (r < N0) { transpose_item<1>(p.in[I_WIN], INC, 64 * (r / 272), 32 * (r % 272), WinT, D, 0, 0, scr, lane); continue; } r -= N0;
        if (r < N1) { transpose_item<0>(p.in[I_WK], XW, 64 * (r / 16), 32 * (r % 16), WinT, D, 8704, 0, scr, lane); continue; } r -= N1;
        if (r < N1) { transpose_item<0>(p.in[I_WV], XW, 64 * (r / 16), 32 * (r % 16), WinT, D, 9216, 0, scr, lane); continue; } r -= N1;
        if (r < N3) { transpose_item<0>(p.in[I_LWO], D, 64 * (r / 32), 32 * (r % 32), WcatT, 2048, 0, 0, scr, lane); continue; } r -= N3;
        if (r < N3) { transpose_item<0>(p.in[I_SWO], D, 64 * (r / 32), 32 * (r % 32), WcatT, 2048, 0, 768, scr, lane); continue; } r -= N3;
        if (r < N5) { transpose_item<0>(p.in[I_XWO], D, 64 * (r / 32), 32 * (r % 32), WcatT, 2048, 0, 1536, scr, lane); continue; } r -= N5;
        if (r < N6) { transpose_item<0>(p.in[I_WOUT], D, 64 * (r / 32), 32 * (r % 32), WoutT, D, 0, 0, scr, lane); continue; } r -= N6;
        if (r < N7) { const int blk = r / 8, q = r % 8; transpose_item<0>(p.in[I_WA] + (size_t)blk * 128 * 128, 128, 64 * (q / 4), 32 * (q % 4), WgT, 128, blk * 256, 0, scr, lane); continue; } r -= N7;
        { const int blk = r / 8, q = r % 8; transpose_item<0>(p.in[I_WX] + (size_t)blk * 128 * 128, 128, 64 * (q / 4), 32 * (q % 4), WgT, 128, blk * 256 + 128, 0, scr, lane); }
    }
    if (part) return;
    if (gw < 12) {
        const int ch = gw * 64 + lane; const float lam = p.in[I_LAM][ch];
        ((float*)(p.ws + WS_WG + 524288))[ch] = -8.0f * ((lam > 15.f) ? __expf(-lam) : log1pf(__expf(-lam))); }
    for (int m = gw; m < UROWS; m += NGW) {
        bf16_t* orow = U + (size_t)m * D;
        if (m < MP) rms_row(p.in[I_XP] + (size_t)m * D, p.in[I_NG], orow, lane);
        else if (m < MT) rms_row(p.in[I_XS] + (size_t)(m - MP) * D, p.in[I_NG], orow, lane);
        else if (m < MPAD) { u32x2* o8 = (u32x2*)orow + lane;
#pragma unroll
            for (int j = 0; j < 4; ++j) o8[64 * j] = (u32x2){0u, 0u}; }
        else rms_row(p.in[I_MEM] + (size_t)(m - MPAD) * D, p.in[I_MNG], orow, lane);
    }
}

struct Sched1 {
    int G, c;
    __device__ __forceinline__ bool next(int i, Unit& u) const {
        const int L = i * G + c; constexpr int nM = 65, nN = 34, nwg = nM * nN;
        if (L >= nwg + 32) return false;
        u.seg = 0;
        if (L < 32) { u.pm = 65 + (L >> 2); u.pn = 34 + (L & 3); return true; }
        int wgid = L - 32; { const int q = nwg / 8, r = nwg % 8, xcd = wgid % 8, off = wgid / 8; wgid = (xcd < r ? xcd * (q + 1) : r * (q + 1) + (xcd - r) * q) + off; }
        const int nig = 8 * nN, gid = wgid / nig, fm = gid * 8, gsz = (nM - fm) < 8 ? (nM - fm) : 8;
        u.pm = fm + ((wgid % nig) % gsz); u.pn = (wgid % nig) / gsz; return true;
    }
    __device__ __forceinline__ size_t a_off(const Unit& u) const { return (size_t)u.pm * 256 * D * 2; }
    __device__ __forceinline__ size_t b_off(const Unit& u) const { return (size_t)u.pn * 256 * D * 2; }
    __device__ __forceinline__ int nt(const Unit&) const { return D / 64; }
};
constexpr float QSCALE = 0.08838834764831845f * 1.4426950408889634f;
__device__ __forceinline__ int vt_pos(int m) { const int kl = m & 15; return (m & ~15) + 8 * ((kl >> 2) & 1) + 4 * (kl >> 3) + (kl & 3); }
struct Epi1 {
    static constexpr bool PERM = true;
    bf16_t* P; float* outK; float* outV; bf16_t* KB; bf16_t* VtB; const float* scw;
    __device__ __forceinline__ bool operator()(f32x4 (&acc)[2][2][4][2], const Unit& u, int wr, int wc, int fr, int fq) const {
        const int pn = u.pn; const int row0 = u.pm * 256 + wr * 64 + fr;
        if (pn >= 34) {
            const int mr0 = row0 - MPAD; const bool isV = pn >= 36;
#pragma unroll
            for (int ai = 0; ai < 2; ++ai)
#pragma unroll
                for (int m = 0; m < 4; ++m) { const int mr = mr0 + ai * 128 + m * 16;
#pragma unroll
                    for (int bj = 0; bj < 2; ++bj) { const int col = (pn - (isV ? 36 : 34)) * 256 + bj * 128 + wc * 32 + 8 * fq; const f32x4 v0 = acc[ai][bj][m][0], v1 = acc[ai][bj][m][1];
                        float* o = (isV ? outV : outK) + (size_t)mr * XW + col; *(f32x4*)o = v0; *(f32x4*)(o + 4) = v1;
                        if (!isV) { u32x4 w; w.x = cvt_pk_bf16(v0[0], v0[1]); w.y = cvt_pk_bf16(v0[2], v0[3]); w.z = cvt_pk_bf16(v1[0], v1[1]); w.w = cvt_pk_bf16(v1[2], v1[3]); *(u32x4*)(KB + (size_t)mr * XW + col) = w; }
                        else { const int b = mr >> 8, mm = mr & 255, h = col >> 7, d0 = col & 127; bf16_t* vt = VtB + ((size_t)(b * 4 + h) * 128 + d0) * 256 + vt_pos(mm);
                            const unsigned w0 = cvt_pk_bf16(v0[0], v0[1]), w1 = cvt_pk_bf16(v0[2], v0[3]), w2 = cvt_pk_bf16(v1[0], v1[1]), w3 = cvt_pk_bf16(v1[2], v1[3]);
                            vt[0] = (bf16_t)w0; vt[256] = (bf16_t)(w0 >> 16); vt[512] = (bf16_t)w1; vt[768] = (bf16_t)(w1 >> 16); vt[1024] = (bf16_t)w2; vt[1280] = (bf16_t)(w2 >> 16); vt[1536] = (bf16_t)w3; vt[1792] = (bf16_t)(w3 >> 16); } } }
            return false;
        }
        if (pn >= 6 && pn < 18) {
            const int ch0 = 64 * (pn - 6) + 16 * wc + 4 * fq;
            if (u.pm >= 64) {
#pragma unroll
                for (int ai = 0; ai < 2; ++ai)
#pragma unroll
                    for (int m = 0; m < 4; ++m) { const f32x4 sb = acc[ai][0][m][0], scg = acc[ai][0][m][1], sh = acc[ai][1][m][0], sg = acc[ai][1][m][1];
                        bf16_t* prow = P + (size_t)(row0 + ai * 128 + m * 16) * PLD;
                        u32x2 wc_, wg_;
                        wc_.x = cvt_pk_bf16(scg[0] * sh[0], scg[1] * sh[1]); wc_.y = cvt_pk_bf16(scg[2] * sh[2], scg[3] * sh[3]);
                        wg_.x = cvt_pk_bf16(silu(sg[0]) * sb[0], silu(sg[1]) * sb[1]); wg_.y = cvt_pk_bf16(silu(sg[2]) * sb[2], silu(sg[3]) * sb[3]);
                        *(u32x2*)(prow + PC_CIN + ch0) = wc_; *(u32x2*)(prow + PC_GB + ch0) = wg_; }
                return false;
            }
            const f32x4 w0 = *(const f32x4*)(scw + ch0), w1 = *(const f32x4*)(scw + LW + ch0), w2 = *(const f32x4*)(scw + 2 * LW + ch0);
#pragma unroll
            for (int ai = 0; ai < 2; ++ai) {
                f32x4 cprev = (f32x4){0.f, 0.f, 0.f, 0.f};
#pragma unroll
                for (int m = 0; m < 4; ++m) { const f32x4 sb = acc[ai][0][m][0], scg = acc[ai][0][m][1], sh = acc[ai][1][m][0], sg = acc[ai][1][m][1];
                    bf16_t* prow = P + (size_t)(row0 + ai * 128 + m * 16) * PLD;
                    const f32x4 cin = scg * sh; f32x4 gp, c1, c2;
#pragma unroll
                    for (int i = 0; i < 4; ++i) { gp[i] = silu(sg[i]) * sb[i];
                        const float v1 = (fr == 15) ? cprev[i] : cin[i], v2 = (fr >= 14) ? cprev[i] : cin[i];
                        c1[i] = __int_as_float(__builtin_amdgcn_update_dpp(0, __float_as_int(v1), 0x121, 0xf, 0xf, false));
                        c2[i] = __int_as_float(__builtin_amdgcn_update_dpp(0, __float_as_int(v2), 0x122, 0xf, 0xf, false)); }
                    const bool special = (m == 0 && fr < 2);
                    const f32x4 gb = gp * (w0 * c2 + w1 * c1 + w2 * cin);
                    const f32x4 o = special ? gp : gb;
                    u32x2 wg_; wg_.x = cvt_pk_bf16(o[0], o[1]); wg_.y = cvt_pk_bf16(o[2], o[3]);
                    *(u32x2*)(prow + PC_GB + ch0) = wg_;
                    if (special || (m == 3 && fr >= 14)) { u32x2 wc_; wc_.x = cvt_pk_bf16(cin[0], cin[1]); wc_.y = cvt_pk_bf16(cin[2], cin[3]); *(u32x2*)(prow + PC_CIN + ch0) = wc_; }
                    cprev = cin; }
            }
            return false;
        }
        int mode, dcol;
        if (pn < 3) { mode = 0; dcol = PC_LX + 256 * pn; }
        else if (pn < 6) { mode = 1; dcol = PC_GA + 256 * (pn - 3); }
        else if (pn < 20) { mode = 2; dcol = PC_Q + 256 * (pn - 18); }
        else if (pn < 22) { mode = 1; dcol = PC_GC + 256 * (pn - 20); }
        else { mode = 3; dcol = PC_G + 256 * (pn - 22); }
#define EPI1_STORE_LOOP(XF) do { _Pragma("unroll") for (int ai = 0; ai < 2; ++ai) _Pragma("unroll") for (int m = 0; m < 4; ++m) { \
            bf16_t* prow = P + (size_t)(row0 + ai * 128 + m * 16) * PLD + dcol + wc * 64 + 8 * fq; \
            _Pragma("unroll") for (int bj = 0; bj < 2; ++bj) { f32x4 v0 = acc[ai][bj][m][0], v1 = acc[ai][bj][m][1]; \
                _Pragma("unroll") for (int i = 0; i < 4; ++i) { v0[i] = XF(v0[i]); v1[i] = XF(v1[i]); } \
                u32x4 w; w.x = cvt_pk_bf16(v0[0], v0[1]); w.y = cvt_pk_bf16(v0[2], v0[3]); w.z = cvt_pk_bf16(v1[0], v1[1]); w.w = cvt_pk_bf16(v1[2], v1[3]); \
                *(u32x4*)(prow + bj * 32) = w; } } } while (0)
#define EPI1_ID(x) (x)
#define EPI1_SC(x) ((x) * QSCALE)
        if (mode == 0) EPI1_STORE_LOOP(EPI1_ID); else if (mode == 1) EPI1_STORE_LOOP(silu); else if (mode == 2) EPI1_STORE_LOOP(EPI1_SC); else EPI1_STORE_LOOP(sigm);
#undef EPI1_STORE_LOOP
#undef EPI1_ID
#undef EPI1_SC
        return false;
    }
};

struct Sched2 {
    int G, c, su0, su1;
    __device__ __forceinline__ bool next(int i, Unit& u) const {
        const int su = su0 + c + (i / 3) * G; if (su >= su1) return false;
        u.pm = su >> 2; u.pn = su & 3; u.seg = i % 3; return true;
    }
    __device__ __forceinline__ size_t a_off(const Unit& u) const { return ((size_t)u.pm * 256 * PLD + u.seg * 768) * 2; }
    __device__ __forceinline__ size_t b_off(const Unit& u) const { return ((size_t)u.pn * 256 * 2048 + u.seg * 768) * 2; }
    __device__ __forceinline__ int nt(const Unit& u) const { return u.seg < 2 ? 12 : 8; }
};
struct Epi2 {
    static constexpr bool PERM = true;
    bf16_t* P;
    __device__ __forceinline__ bool operator()(f32x4 (&acc)[2][2][4][2], const Unit& u, int wr, int wc, int fr, int fq) const {
        const int row0 = u.pm * 256 + wr * 64 + fr, col0 = u.pn * 256 + wc * 32 + 8 * fq, seg = u.seg;
#pragma unroll
        for (int ai = 0; ai < 2; ++ai) {
            u32x4 nw[4][2], dw[4][2];
#pragma unroll
            for (int m = 0; m < 4; ++m) { const bf16_t* prow = P + (size_t)(row0 + ai * 128 + m * 16) * PLD + PC_G + seg * 1024 + col0;
#pragma unroll
                for (int bj = 0; bj < 2; ++bj) { nw[m][bj] = *(const u32x4*)(prow + bj * 128); if (seg < 2) dw[m][bj] = *(const u32x4*)(prow + 1024 + bj * 128); } }
#pragma unroll
            for (int m = 0; m < 4; ++m) { bf16_t* prow = P + (size_t)(row0 + ai * 128 + m * 16) * PLD;
#pragma unroll
                for (int bj = 0; bj < 2; ++bj) { const int col = col0 + bj * 128;
                    float num[8], den[8];
                    unpack8(nw[m][bj], num);
                    if (seg < 2) { unpack8(dw[m][bj], den);
#pragma unroll
                        for (int i = 0; i < 8; ++i) num[i] = num[i] * __builtin_amdgcn_rcpf(den[i]); }
                    f32x4 v0 = acc[ai][bj][m][0], v1 = acc[ai][bj][m][1];
#pragma unroll
                    for (int i = 0; i < 4; ++i) { v0[i] *= num[i]; v1[i] *= num[4 + i]; }
                    if (seg < 2) { acc[ai][bj][m][0] = v0; acc[ai][bj][m][1] = v1; }
                    else { u32x4 w; w.x = cvt_pk_bf16(v0[0], v0[1]); w.y = cvt_pk_bf16(v0[2], v0[3]); w.z = cvt_pk_bf16(v1[0], v1[1]); w.w = cvt_pk_bf16(v1[2], v1[3]);
                        *(u32x4*)(prow + PC_MRG + col) = w; } } }
            asm volatile("" ::: "memory"); }
        return seg < 2;
    }
};
struct Sched3 {
    int G, c, su0, su1;
    __device__ __forceinline__ bool next(int i, Unit& u) const { const int su = su0 + c + i * G; if (su >= su1) return false; u.pm = su >> 2; u.pn = su & 3; u.seg = 0; return true; }
    __device__ __forceinline__ size_t a_off(const Unit& u) const { return ((size_t)u.pm * 256 * PLD + PC_MRG) * 2; }
    __device__ __forceinline__ size_t b_off(const Unit& u) const { return (size_t)u.pn * 256 * D * 2; }
    __device__ __forceinline__ int nt(const Unit&) const { return D / 64; }
};
struct Epi3 {
    static constexpr bool PERM = false;
    const float* xp; const float* xs; float* out; float* rss;
    __device__ __forceinline__ bool operator()(f32x4 (&acc)[2][2][4][2], const Unit& u, int wr, int wc, int fr, int fq) const {
        const int row0 = u.pm * 256 + wr * 64 + fr, col0 = u.pn * 256 + wc * 32 + 4 * fq;
#pragma unroll
        for (int ai = 0; ai < 2; ++ai)
#pragma unroll
            for (int mp = 0; mp < 2; ++mp) {
                f32x4 xv[2][2][2];
#pragma unroll
                for (int mm = 0; mm < 2; ++mm) { const int row = row0 + ai * 128 + (2 * mp + mm) * 16; const bool ok = row < MT;
                    const float* xrow = (row < MP ? xp + (size_t)row * D : xs + (size_t)((ok ? row : MP) - MP) * D) + col0;
#pragma unroll
                    for (int bj = 0; bj < 2; ++bj)
#pragma unroll
                        for (int n = 0; n < 2; ++n) xv[mm][bj][n] = *(const f32x4*)(xrow + bj * 128 + n * 16); }
#pragma unroll
                for (int mm = 0; mm < 2; ++mm) { const int m = 2 * mp + mm; const int row = row0 + ai * 128 + m * 16; const bool ok = row < MT; float ss = 0.f;
                    float* orow = out + (size_t)row * D + col0;
#pragma unroll
                    for (int bj = 0; bj < 2; ++bj)
#pragma unroll
                        for (int n = 0; n < 2; ++n) { const f32x4 v = xv[mm][bj][n] + acc[ai][bj][m][n];
                            if (ok) *(f32x4*)(orow + bj * 128 + n * 16) = v; ss += (v[0] * v[0] + v[1] * v[1]) + (v[2] * v[2] + v[3] * v[3]); }
                    ss += __shfl_xor(ss, 16); ss += __shfl_xor(ss, 32);
                    if (ok && fq == 0) rss[(size_t)row * 16 + u.pn * 4 + wc] = ss; }
                asm volatile("" ::: "memory"); }
        return false;
    }
};

struct Epi3F {
    static constexpr bool PERM = false;
    const float* xp; float* out; const float* fg; float* xbuf; unsigned* cnt; LAS unsigned char* lds;
    __device__ __forceinline__ bool operator()(f32x4 (&acc)[2][2][4][2], const Unit& u, int wr, int wc, int fr, int fq) const {
        const int tid = threadIdx.x, lane = tid & 63, wid = tid >> 6;
        LAS float* PT = (LAS float*)(lds + 131072); LAS float* ST = PT + 1024;
        const int row0 = u.pm * 256 + wr * 64 + fr, col0 = u.pn * 256 + wc * 32 + 4 * fq;
#pragma unroll
        for (int ai = 0; ai < 2; ++ai)
#pragma unroll
            for (int mp = 0; mp < 2; ++mp) {
                f32x4 xv[2][2][2];
#pragma unroll
                for (int mm = 0; mm < 2; ++mm) { const float* xrow = xp + (size_t)(row0 + ai * 128 + (2 * mp + mm) * 16) * D + col0;
#pragma unroll
                    for (int bj = 0; bj < 2; ++bj)
#pragma unroll
                        for (int n = 0; n < 2; ++n) xv[mm][bj][n] = *(const f32x4*)(xrow + bj * 128 + n * 16); }
#pragma unroll
                for (int mm = 0; mm < 2; ++mm) { const int m = 2 * mp + mm; float ss = 0.f;
#pragma unroll
                    for (int bj = 0; bj < 2; ++bj)
#pragma unroll
                        for (int n = 0; n < 2; ++n) { const f32x4 v = xv[mm][bj][n] + acc[ai][bj][m][n]; acc[ai][bj][m][n] = v; ss += (v[0] * v[0] + v[1] * v[1]) + (v[2] * v[2] + v[3] * v[3]); }
                    ss += __shfl_xor(ss, 16); ss += __shfl_xor(ss, 32);
                    if (fq == 0) PT[(ai * 128 + wr * 64 + m * 16 + fr) * 4 + wc] = ss; }
                asm volatile("" ::: "memory"); }
        __syncthreads();
        if (tid < 256) { const f32x4 pt = *(const LAS f32x4*)(PT + tid * 4); const float t = (pt[0] + pt[1]) + (pt[2] + pt[3]);
            __hip_atomic_store(xbuf + ((size_t)u.pm * 256 + tid) * 4 + u.pn, t, __ATOMIC_RELAXED, __HIP_MEMORY_SCOPE_AGENT);
            asm volatile("s_waitcnt vmcnt(0)" ::: "memory");
            if (lane == 0) __hip_atomic_fetch_add(cnt + 64 * u.pm, 1u, __ATOMIC_RELAXED, __HIP_MEMORY_SCOPE_AGENT); }
        if (wid == 0) { unsigned sp = 0;
            while ((unsigned)__builtin_amdgcn_readfirstlane(__hip_atomic_load(cnt + 64 * u.pm, __ATOMIC_RELAXED, __HIP_MEMORY_SCOPE_AGENT)) < 16u) { __builtin_amdgcn_s_sleep(2); if (++sp > (1u << 22)) break; }
            __builtin_amdgcn_fence(__ATOMIC_ACQUIRE, "agent"); }
        asm volatile("s_waitcnt vmcnt(0)" ::: "memory");
        __syncthreads();
        if (tid < 256) { const float* sl = xbuf + ((size_t)u.pm * 256 + tid) * 4; float t = 0.f;
#pragma unroll
            for (int k = 0; k < 4; ++k) t += __hip_atomic_load(sl + k, __ATOMIC_RELAXED, __HIP_MEMORY_SCOPE_AGENT);
            ST[tid] = 1.f / sqrtf(t * (1.f / D) + EPS); }
        __syncthreads();
        f32x4 gg[2][2];
#pragma unroll
        for (int bj = 0; bj < 2; ++bj)
#pragma unroll
            for (int n = 0; n < 2; ++n) gg[bj][n] = *(const f32x4*)(fg + col0 + bj * 128 + n * 16);
#pragma unroll
        for (int ai = 0; ai < 2; ++ai)
#pragma unroll
            for (int m = 0; m < 4; ++m) { const int rl = ai * 128 + wr * 64 + m * 16 + fr; const float rs = ST[rl]; float* orow = out + (size_t)(u.pm * 256 + rl) * D + col0;
#pragma unroll
                for (int bj = 0; bj < 2; ++bj)
#pragma unroll
                    for (int n = 0; n < 2; ++n) __builtin_nontemporal_store(acc[ai][bj][m][n] * rs * gg[bj][n], (f32x4*)(orow + bj * 128 + n * 16)); }
        return false;
    }
};

__device__ __forceinline__ void attn_prompt_unit(LAS unsigned char* lds, bf16_t* P, const bf16_t* KB, const bf16_t* VtB, int unit, bool st = true) {
    const int tid = threadIdx.x, lane = tid & 63, wave = tid >> 6, r32 = lane & 31, hi = lane >> 5;
    const int b = unit >> 5, h = (unit >> 3) & 3, qb = unit & 7;
    LAS unsigned char* ldsK = lds; LAS unsigned char* ldsV = lds + 256 * 272;
    __syncthreads();
    for (int i = tid; i < 256 * 16; i += 512) { const int kv = i >> 4, c = i & 15; *(LAS u32x4*)(ldsK + kv * 272 + c * 16) = *(const u32x4*)(KB + (size_t)(b * 256 + kv) * XW + h * 128 + c * 8); }
    for (int i = tid; i < 128 * 32; i += 512) { const int d = i >> 5, c = i & 31; *(LAS u32x4*)(ldsV + d * 528 + c * 16) = *(const u32x4*)(VtB + ((size_t)(b * 4 + h) * 128 + d) * 256 + c * 8); }
    const size_t tok = (size_t)b * SEQ + qb * 256 + wave * 32;
    bf16x8 qf[8];
    { const bf16_t* qrow = P + (tok + r32) * PLD + PC_Q + h * 128 + 8 * hi;
#pragma unroll
        for (int s = 0; s < 8; ++s) qf[s] = *(const bf16x8*)(qrow + 16 * s); }
    __syncthreads();
    f32x16 sacc[8];
#pragma unroll
    for (int t = 0; t < 8; ++t) {
#pragma unroll
        for (int r = 0; r < 16; ++r) sacc[t][r] = 0.f;
#pragma unroll
        for (int s = 0; s < 8; ++s) { const bf16x8 kf = *(const LAS bf16x8*)(ldsK + (32 * t + r32) * 272 + (16 * s + 8 * hi) * 2); sacc[t] = __builtin_amdgcn_mfma_f32_32x32x16_bf16(kf, qf[s], sacc[t], 0, 0, 0); }
    }
    float mx = -3.0e38f;
#pragma unroll
    for (int t = 0; t < 8; ++t)
#pragma unroll
        for (int r = 0; r < 16; ++r) mx = fmaxf(mx, sacc[t][r]);
    mx = fmaxf(mx, __shfl_xor(mx, 32));
    float sum = 0.f;
#pragma unroll
    for (int t = 0; t < 8; ++t)
#pragma unroll
        for (int r = 0; r < 16; ++r) { const float e = __builtin_amdgcn_exp2f(sacc[t][r] - mx); sacc[t][r] = e; sum += e; }
    sum += __shfl_xor(sum, 32);
    const float inv = __builtin_amdgcn_rcpf(sum);
#pragma unroll
    for (int t = 0; t < 8; ++t)
#pragma unroll
        for (int r = 0; r < 16; ++r) sacc[t][r] *= inv;
#pragma unroll 1
    for (int dp = 0; dp < 2; ++dp) {
        f32x16 o[2];
#pragma unroll
        for (int dt = 0; dt < 2; ++dt)
#pragma unroll
            for (int r = 0; r < 16; ++r) o[dt][r] = 0.f;
        const LAS unsigned char* vbase = ldsV + (64 * dp + r32) * 528 + 16 * hi;
#pragma unroll
        for (int t = 0; t < 8; ++t) {
#pragma unroll
            for (int s2 = 0; s2 < 2; ++s2) {
                u32x4 pw; pw.x = cvt_pk_bf16(sacc[t][8 * s2 + 0], sacc[t][8 * s2 + 1]); pw.y = cvt_pk_bf16(sacc[t][8 * s2 + 2], sacc[t][8 * s2 + 3]);
                pw.z = cvt_pk_bf16(sacc[t][8 * s2 + 4], sacc[t][8 * s2 + 5]); pw.w = cvt_pk_bf16(sacc[t][8 * s2 + 6], sacc[t][8 * s2 + 7]);
                const bf16x8 pa = __builtin_bit_cast(bf16x8, pw);
#pragma unroll
                for (int dt = 0; dt < 2; ++dt) { const bf16x8 vf = *(const LAS bf16x8*)(vbase + dt * 32 * 528 + (32 * t + 16 * s2) * 2); o[dt] = __builtin_amdgcn_mfma_f32_32x32x16_bf16(vf, pa, o[dt], 0, 0, 0); }
            }
            __builtin_amdgcn_sched_barrier(0);
        }
        bf16_t* grow = P + (tok + r32) * PLD + PC_GC + h * 128 + 64 * dp + 8 * hi;
        __builtin_amdgcn_sched_barrier(0);
        u32x4 gw[2][2];
#pragma unroll
        for (int dt = 0; dt < 2; ++dt)
#pragma unroll
            for (int pr = 0; pr < 2; ++pr) gw[dt][pr] = *(const u32x4*)(grow + 32 * dt + 16 * pr);
#pragma unroll
        for (int dt = 0; dt < 2; ++dt)
#pragma unroll
            for (int pr = 0; pr < 2; ++pr) { float v[8], g[8]; unpack8(gw[dt][pr], g);
#pragma unroll
                for (int i = 0; i < 4; ++i) { const auto rr = __builtin_amdgcn_permlane32_swap(__float_as_uint(o[dt][8 * pr + i]), __float_as_uint(o[dt][8 * pr + 4 + i]), false, false);
                    v[i] = __uint_as_float(rr[0]); v[4 + i] = __uint_as_float(rr[1]); }
#pragma unroll
                for (int i = 0; i < 8; ++i) v[i] *= g[i];
                const u32x4 w = pack8(v); if (st) *(u32x4*)(grow + 32 * dt + 16 * pr) = w; else asm volatile("" :: "v"(w)); }
        __builtin_amdgcn_sched_barrier(0);
    }
}
__device__ __forceinline__ void attn_sample_unit(LAS unsigned char* lds, bf16_t* P, const float* ck, const float* cv, int unit, bool st = true) {
    const int tid = threadIdx.x, lane = tid & 63, wave = tid >> 6, l32 = lane & 31, half = lane >> 5;
    const int b = unit >> 2, h = unit & 3;
    LAS float* sc = (LAS float*)lds; LAS float* pn = sc + 256; LAS float* red = pn + 256;
    const bf16_t* qrow = P + (size_t)(MP + b) * PLD + PC_Q + h * 128;
    float q4[4]; { const u32x2 w = *(const u32x2*)(qrow + 4 * l32); q4[0] = bflo(w.x); q4[1] = bfhi(w.x); q4[2] = bflo(w.y); q4[3] = bfhi(w.y); }
    const float* kb = ck + ((size_t)b * 256 * 4 + h) * 128 + 4 * l32;
    const int d4 = tid & 31, mg = tid >> 5; const float* vb = cv + ((size_t)b * 256 * 4 + h) * 128 + 4 * d4;
    f32x4 k4[16], v4[16];
#pragma unroll
    for (int ps = 0; ps < 16; ++ps) k4[ps] = __builtin_nontemporal_load((const f32x4*)(kb + (size_t)(ps * 16 + wave * 2 + half) * 512));
#pragma unroll
    for (int i = 0; i < 16; ++i) v4[i] = __builtin_nontemporal_load((const f32x4*)(vb + (size_t)(mg * 16 + i) * 512));
    __syncthreads();
#pragma unroll
    for (int ps = 0; ps < 16; ++ps) { const int m = ps * 16 + wave * 2 + half;
        float s = (k4[ps][0] * q4[0] + k4[ps][1] * q4[1]) + (k4[ps][2] * q4[2] + k4[ps][3] * q4[3]);
        s += __shfl_xor(s, 1); s += __shfl_xor(s, 2); s += __shfl_xor(s, 4); s += __shfl_xor(s, 8); s += __shfl_xor(s, 16);
        if (l32 == 0) sc[m] = s; }
    __syncthreads();
    if (wave == 0) { float v[4]; float mx = -3.0e38f;
#pragma unroll
        for (int j = 0; j < 4; ++j) { v[j] = sc[lane + 64 * j]; mx = fmaxf(mx, v[j]); }
        mx = wave_max(mx); float sm = 0.f;
#pragma unroll
        for (int j = 0; j < 4; ++j) { v[j] = __builtin_amdgcn_exp2f(v[j] - mx); sm += v[j]; }
        sm = wave_sum(sm); const float inv = 1.f / sm;
#pragma unroll
        for (int j = 0; j < 4; ++j) pn[lane + 64 * j] = v[j] * inv; }
    __syncthreads();
    { f32x4 a = (f32x4){0.f, 0.f, 0.f, 0.f};
#pragma unroll
        for (int i = 0; i < 16; ++i) a += v4[i] * pn[mg * 16 + i];
        *(LAS f32x4*)(red + mg * 128 + 4 * d4) = a; }
    __syncthreads();
    if (tid < 128) { float o = 0.f;
#pragma unroll
        for (int g = 0; g < 16; ++g) o += red[g * 128 + tid];
        bf16_t* gp = P + (size_t)(MP + b) * PLD + PC_GC + h * 128 + tid; const float gv = bf2f(*gp); if (st) *gp = (bf16_t)(cvt_pk_bf16(o * gv, 0.f) & 0xffffu); }
}
__device__ __forceinline__ void attn_sample_phase(LAS unsigned char* lds, bf16_t* P, const float* ck, const float* cv, int u0, int nunits, int G) {
    const int tid = threadIdx.x, lane = tid & 63, wave = tid >> 6, l32 = lane & 31, half = lane >> 5;
    LAS float* sc = (LAS float*)lds; LAS float* pn = sc + 256; LAS float* red = pn + 256;
    const int d4 = tid & 31, mg = tid >> 5;
    if (u0 >= nunits) return;
    f32x4 k4[16], v4[16]; float q4[4];
#define AS_LOADK(uu) do { const int _b = (uu) >> 2, _h = (uu) & 3; const u32x2 _w = *(const u32x2*)(P + (size_t)(MP + _b) * PLD + PC_Q + _h * 128 + 4 * l32); \
        q4[0] = bflo(_w.x); q4[1] = bfhi(_w.x); q4[2] = bflo(_w.y); q4[3] = bfhi(_w.y); const float* _kb = ck + ((size_t)_b * 256 * 4 + _h) * 128 + 4 * l32; \
        _Pragma("unroll") for (int ps = 0; ps < 16; ++ps) k4[ps] = __builtin_nontemporal_load((const f32x4*)(_kb + (size_t)(ps * 16 + wave * 2 + half) * 512)); } while (0)
#define AS_LOADV(uu) do { const int _b = (uu) >> 2, _h = (uu) & 3; const float* _vb = cv + ((size_t)_b * 256 * 4 + _h) * 128 + 4 * d4; \
        _Pragma("unroll") for (int i = 0; i < 16; ++i) v4[i] = __builtin_nontemporal_load((const f32x4*)(_vb + (size_t)(mg * 16 + i) * 512)); } while (0)
    AS_LOADK(u0); AS_LOADV(u0);
    for (int u = u0; u < nunits; u += G) {
        const int b = u >> 2, h = u & 3; const bool hn = (u + G) < nunits;
        float sv[16];
#pragma unroll
        for (int ps = 0; ps < 16; ++ps) { float s = (k4[ps][0] * q4[0] + k4[ps][1] * q4[1]) + (k4[ps][2] * q4[2] + k4[ps][3] * q4[3]);
            s += __shfl_xor(s, 1); s += __shfl_xor(s, 2); s += __shfl_xor(s, 4); s += __shfl_xor(s, 8); s += __shfl_xor(s, 16); sv[ps] = s; }
        if (hn) AS_LOADK(u + G);
        __syncthreads();
#pragma unroll
        for (int ps = 0; ps < 16; ++ps) if (l32 == 0) sc[ps * 16 + wave * 2 + half] = sv[ps];
        __syncthreads();
        if (wave == 0) { float v[4]; float mx = -3.0e38f;
#pragma unroll
            for (int j = 0; j < 4; ++j) { v[j] = sc[lane + 64 * j]; mx = fmaxf(mx, v[j]); }
            mx = wave_max(mx); float sm = 0.f;
#pragma unroll
            for (int j = 0; j < 4; ++j) { v[j] = __builtin_amdgcn_exp2f(v[j] - mx); sm += v[j]; }
            sm = wave_sum(sm); const float inv = 1.f / sm;
#pragma unroll
            for (int j = 0; j < 4; ++j) pn[lane + 64 * j] = v[j] * inv; }
        __syncthreads();
        { f32x4 a = (f32x4){0.f, 0.f, 0.f, 0.f};
#pragma unroll
            for (int i = 0; i < 16; ++i) a += v4[i] * pn[mg * 16 + i];
            *(LAS f32x4*)(red + mg * 128 + 4 * d4) = a; }
        if (hn) AS_LOADV(u + G);
        __syncthreads();
        if (tid < 128) { float o = 0.f;
#pragma unroll
            for (int g = 0; g < 16; ++g) o += red[g * 128 + tid];
            bf16_t* gp = P + (size_t)(MP + b) * PLD + PC_GC + h * 128 + tid; const float gv = bf2f(*gp); *gp = (bf16_t)(cvt_pk_bf16(o * gv, 0.f) & 0xffffu); }
    }
#undef AS_LOADK
#undef AS_LOADV
}
constexpr int L_XA = 0, L_RAW0 = 17408, L_RAW1 = 34816, L_A = 52224, L_B = L_A + 33792, L_LRU_END = L_B + 33792;
static_assert(L_LRU_END <= 131072, "LRU LDS");
template <int MODE>
__device__ __forceinline__ void lru_phase(LAS unsigned char* lds, const Params& p, bf16_t* P, const bf16_t* WgT, float* agg, bf16_t* CG, int u0, int nunits, int G) {
    const int tid = threadIdx.x, lane = tid & 63, wave = tid >> 6;
    LAS float* LA = (LAS float*)(lds + L_A); LAS float* LB = (LAS float*)(lds + L_B);
    const float* cw = p.in[I_CW]; const float* cb = p.in[I_CB];
    const int ch8 = tid & 15, tl = tid >> 4, col = lane & 15, quad = lane >> 4;
    constexpr int NMT = (MODE == 2) ? 2 : 4, NRR = (MODE == 2) ? 1 : 2, UR = 16 * NMT;
    u32x4 pre[3];
    int buf = 0;
    __syncthreads();
    if (MODE != 2 && u0 < nunits) {
        const int n = u0 % 6, c = (u0 / 6) % NCH, b = u0 / (6 * NCH), t0 = c * TC;
#pragma unroll
        for (int k = 0; k < 3; ++k) { const int i = tid + 512 * k; const int r = i >> 4, c16 = i & 15, t = t0 - 3 + r; pre[k] = (u32x4){0u, 0u, 0u, 0u};
            if (i < 67 * 16 && t >= 0) pre[k] = *(const u32x4*)(P + ((size_t)b * SEQ + t) * PLD + PC_LX + n * 128 + 8 * c16); }
#pragma unroll
        for (int k = 0; k < 3; ++k) { const int i = tid + 512 * k; if (i < 67 * 16) *(LAS u32x4*)(lds + L_RAW0 + i * 16) = pre[k]; }
    }
    __syncthreads();
    for (int u = u0; u < nunits; u += G, buf ^= 1) {
        int b, c, n, t0; size_t tokbase;
        if (MODE == 2) { n = u % 6; c = u / 6; b = 0; t0 = 0; tokbase = (size_t)MP + UR * c; }
        else { n = u % 6; c = (u / 6) % NCH; b = u / (6 * NCH); t0 = c * TC; tokbase = (size_t)b * SEQ + t0; }
        const LAS bf16_t* RAW = (const LAS bf16_t*)(lds + (buf ? L_RAW1 : L_RAW0));
        const int chg8 = n * 128 + 8 * ch8;
        float w[4][8], bias[8];
#pragma unroll
        for (int k = 0; k < 4; ++k) { const f32x4 a = *(const f32x4*)(cw + k * LW + chg8), bb = *(const f32x4*)(cw + k * LW + chg8 + 4);
            w[k][0] = a[0]; w[k][1] = a[1]; w[k][2] = a[2]; w[k][3] = a[3]; w[k][4] = bb[0]; w[k][5] = bb[1]; w[k][6] = bb[2]; w[k][7] = bb[3]; }
        { const f32x4 a = *(const f32x4*)(cb + chg8), bb = *(const f32x4*)(cb + chg8 + 4); bias[0] = a[0]; bias[1] = a[1]; bias[2] = a[2]; bias[3] = a[3]; bias[4] = bb[0]; bias[5] = bb[1]; bias[6] = bb[2]; bias[7] = bb[3]; }
#pragma unroll
        for (int rr = 0; rr < NRR; ++rr) { const int tt = tl + 32 * rr; float xc[8];
#pragma unroll
            for (int j = 0; j < 8; ++j) xc[j] = bias[j];
            if (MODE != 2) {
#pragma unroll
                for (int k = 0; k < 4; ++k) { const u32x4 xw = *(const LAS u32x4*)(RAW + (tt + k) * 128 + 8 * ch8); float x[8]; unpack8(xw, x);
#pragma unroll
                    for (int j = 0; j < 8; ++j) xc[j] += w[k][j] * x[j];
                    if (k == 3 && c == NCH - 1 && tt >= 61) { float* o = p.out + O_PLC + ((size_t)b * 3 + (tt - 61)) * LW + chg8; *(f32x4*)o = (f32x4){x[0], x[1], x[2], x[3]}; *(f32x4*)(o + 4) = (f32x4){x[4], x[5], x[6], x[7]}; } }
            } else {
                const int smp = UR * c + tt; const float* sl = p.in[I_SLC] + (size_t)smp * 3 * LW + chg8; float* so = p.out + O_SLC + (size_t)smp * 3 * LW + chg8;
#pragma unroll
                for (int k = 0; k < 3; ++k) { const f32x4 a = *(const f32x4*)(sl + k * LW), bb = *(const f32x4*)(sl + k * LW + 4);
                    const float x[8] = {a[0], a[1], a[2], a[3], bb[0], bb[1], bb[2], bb[3]};
#pragma unroll
                    for (int j = 0; j < 8; ++j) xc[j] += w[k][j] * x[j];
                    if (k > 0) { *(f32x4*)(so + (k - 1) * LW) = a; *(f32x4*)(so + (k - 1) * LW + 4) = bb; } }
                float x[8]; unpack8(*(const u32x4*)(P + (tokbase + tt) * PLD + PC_LX + chg8), x);
#pragma unroll
                for (int j = 0; j < 8; ++j) xc[j] += w[3][j] * x[j];
                *(f32x4*)(so + 2 * LW) = (f32x4){x[0], x[1], x[2], x[3]}; *(f32x4*)(so + 2 * LW + 4) = (f32x4){x[4], x[5], x[6], x[7]};
            }
            *(LAS u32x4*)(lds + L_XA + tt * 272 + ch8 * 16) = pack8(xc); }
        const int d = 16 * wave + col, chg = n * 128 + d;
        const bf16_t* wrow = WgT + ((size_t)n * 256 + d) * 128 + 8 * quad;
        bf16x8 bwa[4], bwx[4];
#pragma unroll
        for (int ks = 0; ks < 4; ++ks) { bwa[ks] = *(const bf16x8*)(wrow + 32 * ks); bwx[ks] = *(const bf16x8*)(wrow + 128 * 128 + 32 * ks); }
        const float bav = p.in[I_BA][chg], bxv = p.in[I_BX][chg], cl = ((const float*)(p.ws + WS_WG + 524288))[chg];
        const float bav2 = -1.4426950408889634f * bav, bxv2 = -1.4426950408889634f * bxv, cl2 = 1.4426950408889634f * cl;
        __syncthreads();
        const int un = u + G; const bool hn = (MODE != 2) && (un < nunits);
        if (hn) { const int n2 = un % 6, c2 = (un / 6) % NCH, b2 = un / (6 * NCH), t02 = c2 * TC;
#pragma unroll
            for (int k = 0; k < 3; ++k) { const int i = tid + 512 * k; const int r = i >> 4, c16 = i & 15, t = t02 - 3 + r; pre[k] = (u32x4){0u, 0u, 0u, 0u};
                if (i < 67 * 16 && t >= 0) pre[k] = *(const u32x4*)(P + ((size_t)b2 * SEQ + t) * PLD + PC_LX + n2 * 128 + 8 * c16); } }
        u32x4 slw[NRR];
#pragma unroll
        for (int rr = 0; rr < NRR; ++rr) slw[rr] = *(const u32x4*)(P + (tokbase + tl + 32 * rr) * PLD + PC_GA + chg8);
        f32x4 aa[NMT], ax[NMT];
#pragma unroll
        for (int m = 0; m < NMT; ++m) { aa[m] = (f32x4){0.f, 0.f, 0.f, 0.f}; ax[m] = (f32x4){0.f, 0.f, 0.f, 0.f}; }
#pragma unroll
        for (int ks = 0; ks < 4; ++ks)
#pragma unroll
            for (int m = 0; m < NMT; ++m) { const bf16x8 af = *(const LAS bf16x8*)(lds + L_XA + (16 * m + col) * 272 + (32 * ks + 8 * quad) * 2);
                aa[m] = __builtin_amdgcn_mfma_f32_16x16x32_bf16(af, bwa[ks], aa[m], 0, 0, 0); ax[m] = __builtin_amdgcn_mfma_f32_16x16x32_bf16(af, bwx[ks], ax[m], 0, 0, 0); }
#pragma unroll
        for (int m = 0; m < NMT; ++m)
#pragma unroll
            for (int r = 0; r < 4; ++r) { const int t = 16 * m + 4 * quad + r;
                const float rg = __builtin_amdgcn_rcpf(1.f + __builtin_amdgcn_exp2f(__builtin_fmaf(aa[m][r], -1.4426950408889634f, bav2)));
                const float ig = __builtin_amdgcn_rcpf(1.f + __builtin_amdgcn_exp2f(__builtin_fmaf(ax[m][r], -1.4426950408889634f, bxv2)));
                const float a = __builtin_amdgcn_exp2f(cl2 * rg);
                const float em = __builtin_fmaf(-a, a, 1.0f);
                const float mult = __builtin_amdgcn_sqrtf(fmaxf(em, 0.f)); const float xcv = bf2f(*(const LAS bf16_t*)(lds + L_XA + t * 272 + d * 2));
                aa[m][r] = a; ax[m][r] = mult * ig * xcv; }
        if (MODE == 2) {
            const float* h0 = p.in[I_SH]; float* ho = p.out + O_SH;
#pragma unroll
            for (int m = 0; m < NMT; ++m)
#pragma unroll
                for (int r = 0; r < 4; ++r) { const int t = 16 * m + 4 * quad + r; const size_t idx = (size_t)(UR * c + t) * LW + chg; const float h = aa[m][r] * h0[idx] + ax[m][r]; ho[idx] = h; LB[t * 132 + d] = h; }
        } else {
            float cpc = 1.f, hc = 0.f;
#pragma unroll
            for (int m = 0; m < NMT; ++m) {
                float A = 1.f, H = 0.f;
#pragma unroll
                for (int r = 0; r < 4; ++r) { H = aa[m][r] * H + ax[m][r]; A *= aa[m][r]; }
                float Ai = A, Hi = H;
                { const float Ap = __shfl_up(Ai, 16), Hp = __shfl_up(Hi, 16); if (quad >= 1) { Hi = Ai * Hp + Hi; Ai = Ai * Ap; } }
                { const float Ap = __shfl_up(Ai, 32), Hp = __shfl_up(Hi, 32); if (quad >= 2) { Hi = Ai * Hp + Hi; Ai = Ai * Ap; } }
                float Ae = __shfl_up(Ai, 16), He = __shfl_up(Hi, 16); if (quad == 0) { Ae = 1.f; He = 0.f; }
                const float At = __shfl(Ai, 48 + col), Ht = __shfl(Hi, 48 + col);
                float cp = Ae * cpc, h = Ae * hc + He;
#pragma unroll
                for (int r = 0; r < 4; ++r) { const int t = 16 * m + 4 * quad + r; h = aa[m][r] * h + ax[m][r]; cp *= aa[m][r]; LB[t * 132 + d] = h; LA[t * 132 + d] = cp; }
                hc = At * hc + Ht; cpc = At * cpc;
            }
            if (quad == 0) { float* ag = agg + (((size_t)b * NCH + c) * LW + chg) * 2; *(float2*)ag = make_float2(cpc, hc); }
        }
        if (hn) {
#pragma unroll
            for (int k = 0; k < 3; ++k) { const int i = tid + 512 * k; if (i < 67 * 16) *(LAS u32x4*)(lds + (buf ? L_RAW0 : L_RAW1) + i * 16) = pre[k]; } }
        __syncthreads();
#pragma unroll
        for (int rr = 0; rr < NRR; ++rr) { const int tt = tl + 32 * rr; bf16_t* gp = P + (tokbase + tt) * PLD + PC_GA + chg8;
            float g[8]; unpack8(slw[rr], g); const f32x4 h0 = *(const LAS f32x4*)(LB + tt * 132 + 8 * ch8), h1 = *(const LAS f32x4*)(LB + tt * 132 + 8 * ch8 + 4);
            if (MODE == 0) { const f32x4 c0 = *(const LAS f32x4*)(LA + tt * 132 + 8 * ch8), c1 = *(const LAS f32x4*)(LA + tt * 132 + 8 * ch8 + 4);
                float cgv[8] = {g[0] * c0[0], g[1] * c0[1], g[2] * c0[2], g[3] * c0[3], g[4] * c1[0], g[5] * c1[1], g[6] * c1[2], g[7] * c1[3]};
                *(u32x4*)(CG + (tokbase + tt) * LW + chg8) = pack8(cgv); }
            g[0] *= h0[0]; g[1] *= h0[1]; g[2] *= h0[2]; g[3] *= h0[3]; g[4] *= h1[0]; g[5] *= h1[1]; g[6] *= h1[2]; g[7] *= h1[3];
            *(u32x4*)gp = pack8(g); }
    }
}
__device__ __forceinline__ void lru_fix_item(LAS unsigned char* lds, const Params& p, bf16_t* P, const bf16_t* CG, const float* agg, int item) {
    const int tid = threadIdx.x; const int b = item >> 5, cq = (item >> 2) & 7, ns = item & 3;
    LAS float* HIN = (LAS float*)lds;
    __syncthreads();
    if (tid < 192) { const int ch = 192 * ns + tid; const float* ag = agg + ((size_t)b * NCH * LW + ch) * 2; float h = 0.f;
        const int cend = (cq == 7) ? NCH : 4 * cq + 4;
        for (int c0 = 0; c0 < cend; c0 += 8) { float A8[8], H8[8];
#pragma unroll
            for (int j = 0; j < 8; ++j) { A8[j] = 1.f; H8[j] = 0.f; if (c0 + j < cend) { const float2 v = *(const float2*)(ag + (size_t)(c0 + j) * LW * 2); A8[j] = v.x; H8[j] = v.y; } }
#pragma unroll
            for (int j = 0; j < 8; ++j) { const int cc = c0 + j; if (cc >= 4 * cq && cc < 4 * cq + 4) HIN[(cc - 4 * cq) * 192 + tid] = h; h = A8[j] * h + H8[j]; } }
        if (cq == 7) p.out[O_PH + (size_t)b * LW + ch] = h; }
    __syncthreads();
    if (tid < 504) { const int ch8 = tid % 24, rg = tid / 24; const int chb = 192 * ns + 8 * ch8;
#pragma unroll 1
        for (int cc = (cq == 0 ? 1 : 0); cc < 4; ++cc) {
            const f32x4 ha = *(const LAS f32x4*)(HIN + cc * 192 + 8 * ch8), hb = *(const LAS f32x4*)(HIN + cc * 192 + 8 * ch8 + 4);
            const size_t tok0 = (size_t)b * SEQ + (4 * cq + cc) * TC;
            u32x4 gw_[4], cw_[4];
#pragma unroll
            for (int k = 0; k < 4; ++k) { const int r = rg + 21 * k; if (r < 64) { gw_[k] = __builtin_nontemporal_load((const u32x4*)(P + (tok0 + r) * PLD + PC_GA + chb)); cw_[k] = __builtin_nontemporal_load((const u32x4*)(CG + (tok0 + r) * LW + chb)); } }
#pragma unroll
            for (int k = 0; k < 4; ++k) { const int r = rg + 21 * k; if (r < 64) { float g[8], cgv[8]; unpack8(gw_[k], g); unpack8(cw_[k], cgv);
                g[0] += cgv[0] * ha[0]; g[1] += cgv[1] * ha[1]; g[2] += cgv[2] * ha[2]; g[3] += cgv[3] * ha[3]; g[4] += cgv[4] * hb[0]; g[5] += cgv[5] * hb[1]; g[6] += cgv[6] * hb[2]; g[7] += cgv[7] * hb[3];
                *(u32x4*)(P + (tok0 + r) * PLD + PC_GA + chb) = pack8(g); } }
        }
    }
}
__device__ __forceinline__ void sconv_prompt_unit(const Params& p, bf16_t* P, int unit, bool st = true) {
    const int tid = threadIdx.x; if (tid >= 384) return;
    const int ch8 = tid % 96, tg = tid / 96; const int tokg = unit * 64 + tg * 16; const int b = tokg >> 11, t0 = tokg & (SEQ - 1);
    const float* sw = p.in[I_SCW] + 8 * ch8; float w[3][8];
#pragma unroll
    for (int k = 0; k < 3; ++k) { const f32x4 a = *(const f32x4*)(sw + k * LW), bb = *(const f32x4*)(sw + k * LW + 4); w[k][0] = a[0]; w[k][1] = a[1]; w[k][2] = a[2]; w[k][3] = a[3]; w[k][4] = bb[0]; w[k][5] = bb[1]; w[k][6] = bb[2]; w[k][7] = bb[3]; }
    float c2[8], c1[8];
#pragma unroll
    for (int j = 0; j < 8; ++j) { c2[j] = 0.f; c1[j] = 0.f; }
    if (t0 >= 2) { unpack8(*(const u32x4*)(P + (size_t)(tokg - 2) * PLD + PC_CIN + 8 * ch8), c2); unpack8(*(const u32x4*)(P + (size_t)(tokg - 1) * PLD + PC_CIN + 8 * ch8), c1); }
#pragma unroll 1
    for (int i0 = 0; i0 < 16; i0 += 8) {
        u32x4 cw_[8], gw_[8];
#pragma unroll
        for (int i = 0; i < 8; ++i) { const bf16_t* prow = P + (size_t)(tokg + i0 + i) * PLD; cw_[i] = *(const u32x4*)(prow + PC_CIN + 8 * ch8); gw_[i] = *(const u32x4*)(prow + PC_GB + 8 * ch8); }
#pragma unroll
        for (int i = 0; i < 8; ++i) { bf16_t* prow = P + (size_t)(tokg + i0 + i) * PLD; float c0[8], g[8]; unpack8(cw_[i], c0); unpack8(gw_[i], g);
#pragma unroll
            for (int j = 0; j < 8; ++j) g[j] *= (w[0][j] * c2[j] + w[1][j] * c1[j] + w[2][j] * c0[j]);
            if (st) *(u32x4*)(prow + PC_GB + 8 * ch8) = pack8(g);
            if (t0 + i0 + i >= SEQ - 2) { float* o = p.out + O_PSC + ((size_t)b * 2 + (t0 + i0 + i - (SEQ - 2))) * LW + 8 * ch8; *(f32x4*)o = (f32x4){c0[0], c0[1], c0[2], c0[3]}; *(f32x4*)(o + 4) = (f32x4){c0[4], c0[5], c0[6], c0[7]}; }
#pragma unroll
            for (int j = 0; j < 8; ++j) { c2[j] = c1[j]; c1[j] = c0[j]; } }
    }
}
__device__ __forceinline__ void sconv_fix(const Params& p, bf16_t* P, int bx, int G) {
    const int tid = threadIdx.x;
    const int bxs = (G >= 192) ? bx - 96 : bx;
    if (bxs < 0) return;
    for (int i = bxs * 512 + tid; i < 64 * 4 * 2 * 96; i += G * 512) { const int ch8 = i % 96, ri = i / 96; const int j = ri & 1, g = (ri >> 1) & 3, pm = ri >> 3;
        const int row = 256 * pm + 64 * g + j, t = row & (SEQ - 1);
        const float* sw = p.in[I_SCW] + 8 * ch8; bf16_t* prow = P + (size_t)row * PLD;
        float c0[8], c1[8], c2[8], gv[8];
        unpack8(*(const u32x4*)(prow + PC_CIN + 8 * ch8), c0); unpack8(*(const u32x4*)(prow + PC_GB + 8 * ch8), gv);
#pragma unroll
        for (int k = 0; k < 8; ++k) { c1[k] = 0.f; c2[k] = 0.f; }
        if (t >= 1) unpack8(*(const u32x4*)(prow - PLD + PC_CIN + 8 * ch8), c1);
        if (t >= 2) unpack8(*(const u32x4*)(prow - 2 * PLD + PC_CIN + 8 * ch8), c2);
#pragma unroll
        for (int hh = 0; hh < 2; ++hh) { const f32x4 w0 = *(const f32x4*)(sw + 4 * hh), w1 = *(const f32x4*)(sw + LW + 4 * hh), w2 = *(const f32x4*)(sw + 2 * LW + 4 * hh);
#pragma unroll
            for (int k = 0; k < 4; ++k) gv[4 * hh + k] *= (w0[k] * c2[4 * hh + k] + w1[k] * c1[4 * hh + k] + w2[k] * c0[4 * hh + k]); }
        *(u32x4*)(prow + PC_GB + 8 * ch8) = pack8(gv); }
    for (int i = bxs * 512 + tid; i < NB * 2 * 96; i += G * 512) { const int ch8 = i % 96, ri = i / 96; const int k = ri & 1, b = ri >> 1;
        float c0[8]; unpack8(*(const u32x4*)(P + ((size_t)b * SEQ + SEQ - 2 + k) * PLD + PC_CIN + 8 * ch8), c0);
        float* o = p.out + O_PSC + ((size_t)b * 2 + k) * LW + 8 * ch8; *(f32x4*)o = (f32x4){c0[0], c0[1], c0[2], c0[3]}; *(f32x4*)(o + 4) = (f32x4){c0[4], c0[5], c0[6], c0[7]}; }
}
__device__ __forceinline__ void sconv_sample_unit(const Params& p, bf16_t* P, int unit) {
    for (int idx = threadIdx.x; idx < 32 * 96; idx += 512) { const int smp = unit * 32 + idx / 96, ch8 = idx % 96;
        const float* sw = p.in[I_SCW] + 8 * ch8; const float* st = p.in[I_SSC] + (size_t)smp * 2 * LW + 8 * ch8; float* so = p.out + O_SSC + (size_t)smp * 2 * LW + 8 * ch8;
        bf16_t* prow = P + (size_t)(MP + smp) * PLD; float c0[8], g[8]; unpack8(*(const u32x4*)(prow + PC_CIN + 8 * ch8), c0); unpack8(*(const u32x4*)(prow + PC_GB + 8 * ch8), g);
#pragma unroll
        for (int hh = 0; hh < 2; ++hh) { const f32x4 b0 = *(const f32x4*)(st + 4 * hh), b1 = *(const f32x4*)(st + LW + 4 * hh), w0 = *(const f32x4*)(sw + 4 * hh), w1 = *(const f32x4*)(sw + LW + 4 * hh), w2 = *(const f32x4*)(sw + 2 * LW + 4 * hh);
#pragma unroll
            for (int j = 0; j < 4; ++j) g[4 * hh + j] *= (w0[j] * b0[j] + w1[j] * b1[j] + w2[j] * c0[4 * hh + j]);
            *(f32x4*)(so + 4 * hh) = b1; *(f32x4*)(so + LW + 4 * hh) = (f32x4){c0[4 * hh], c0[4 * hh + 1], c0[4 * hh + 2], c0[4 * hh + 3]}; }
        *(u32x4*)(prow + PC_GB + 8 * ch8) = pack8(g); }
}

__device__ __forceinline__ void sample_g2(LAS unsigned char* lds, bf16_t* P, const bf16_t* WcatT, int bx, int G) {
    const int tid = threadIdx.x, lane = tid & 63, wave = tid >> 6, ti = wave >> 2, role = wave & 3, col = lane & 15, quad = lane >> 4;
    LAS float* red = (LAS float*)lds;
    for (int base = 2 * bx; base < 512; base += 2 * G) {
        const int id = base + ti, mt = id & 7, nt16 = id >> 3;
        __syncthreads();
        if (role < 3) {
            const int koff = 768 * role, nks = role < 2 ? 24 : 16;
            const bf16_t* ap = P + (size_t)(MP + 16 * mt + col) * PLD + koff + 8 * quad;
            const bf16_t* bp = WcatT + (size_t)(16 * nt16 + col) * 2048 + koff + 8 * quad;
            f32x4 acc = (f32x4){0.f, 0.f, 0.f, 0.f};
#pragma unroll 8
            for (int ks = 0; ks < nks; ++ks) { const bf16x8 a = *(const bf16x8*)(ap + 32 * ks), b = *(const bf16x8*)(bp + 32 * ks); acc = __builtin_amdgcn_mfma_f32_16x16x32_bf16(a, b, acc, 0, 0, 0); }
#pragma unroll
            for (int r = 0; r < 4; ++r) acc[r] *= bf2f(P[(size_t)(MP + 16 * mt + 4 * quad + r) * PLD + PC_G + 1024 * role + 16 * nt16 + col]);
            *(LAS f32x4*)(red + ((ti * 3 + role) * 64 + lane) * 4) = acc;
        }
        __syncthreads();
        if (role == 0) {
            const f32x4 v = *(const LAS f32x4*)(red + ((ti * 3 + 0) * 64 + lane) * 4) + *(const LAS f32x4*)(red + ((ti * 3 + 1) * 64 + lane) * 4) + *(const LAS f32x4*)(red + ((ti * 3 + 2) * 64 + lane) * 4);
#pragma unroll
            for (int r = 0; r < 4; ++r) P[(size_t)(MP + 16 * mt + 4 * quad + r) * PLD + PC_MRG + 16 * nt16 + col] = (bf16_t)(cvt_pk_bf16(v[r], 0.f) & 0xffffu);
        }
    }
}
__device__ __forceinline__ void sample_g3(LAS unsigned char* lds, const bf16_t* P, const bf16_t* WoutT, const float* xs, float* out, float* rss2, int bx, int G) {
    const int tid = threadIdx.x, lane = tid & 63, wave = tid >> 6, ti = wave >> 2, role = wave & 3, col = lane & 15, quad = lane >> 4;
    LAS float* red = (LAS float*)lds;
    for (int base = 2 * bx; base < 512; base += 2 * G) {
        const int id = base + ti, mt = id & 7, nt16 = id >> 3;
        __syncthreads();
        {
            const bf16_t* ap = P + (size_t)(MP + 16 * mt + col) * PLD + PC_MRG + 256 * role + 8 * quad;
            const bf16_t* bp = WoutT + (size_t)(16 * nt16 + col) * D + 256 * role + 8 * quad;
            f32x4 acc = (f32x4){0.f, 0.f, 0.f, 0.f};
#pragma unroll
            for (int ks = 0; ks < 8; ++ks) { const bf16x8 a = *(const bf16x8*)(ap + 32 * ks), b = *(const bf16x8*)(bp + 32 * ks); acc = __builtin_amdgcn_mfma_f32_16x16x32_bf16(a, b, acc, 0, 0, 0); }
            *(LAS f32x4*)(red + ((ti * 4 + role) * 64 + lane) * 4) = acc;
        }
        __syncthreads();
        if (role == 0) {
            const f32x4 v = (*(const LAS f32x4*)(red + ((ti * 4 + 0) * 64 + lane) * 4) + *(const LAS f32x4*)(red + ((ti * 4 + 1) * 64 + lane) * 4)) + (*(const LAS f32x4*)(red + ((ti * 4 + 2) * 64 + lane) * 4) + *(const LAS f32x4*)(red + ((ti * 4 + 3) * 64 + lane) * 4));
#pragma unroll
            for (int r = 0; r < 4; ++r) { const int m = 16 * mt + 4 * quad + r, n = 16 * nt16 + col; const float xo = xs[(size_t)m * D + n] + v[r]; out[(size_t)(MP + m) * D + n] = xo;
                float ss = xo * xo; ss += __shfl_xor(ss, 1); ss += __shfl_xor(ss, 2); ss += __shfl_xor(ss, 4); ss += __shfl_xor(ss, 8);
                if (col == 0) rss2[m * 64 + nt16] = ss; }
        }
    }
}

__global__ void __launch_bounds__(512, 2) fwd_kernel(Params p) {
    extern __shared__ __attribute__((aligned(16))) unsigned char lds_raw[];
    LAS unsigned char* lds = (LAS unsigned char*)lds_raw;
    volatile LAS unsigned* MISC = (volatile LAS unsigned*)(lds + 131072 + 8192);
    const int tid = threadIdx.x, G = gridDim.x, bx = blockIdx.x;
    const int vcu = (G % 8 == 0) ? (bx % 8) * (G / 8) + bx / 8 : bx;
    if (tid < 64) MISC[tid] = 0u;
    __syncthreads();
    const int lo = p.ph_lo, hi = p.ph_hi;
    const bool multi = (hi - lo) > 1;
    XcdBarrier bar; bar.bar = (unsigned*)(p.ws + WS_CTL); bar.x = 0; bar.st = nullptr;
    if (multi) bar = xcd_barrier_post((unsigned*)(p.ws + WS_CTL), MISC + 8);
#ifndef PHASE_MASK
#define PHASE_MASK 0x7f
#endif
#ifndef UNIT_MASK
#define UNIT_MASK 0x3f
#endif
#define IN(k) ((((PHASE_MASK) >> (k)) & 1) && lo <= (k) && (k) < hi)
#define SEAM(k) do { if (IN(k) && IN((k) + 1)) xcd_barrier(bar); } while (0)
    bf16_t* P = (bf16_t*)(p.ws + WS_P);
    bf16_t* U = (bf16_t*)((unsigned char*)p.out + DO_U); bf16_t* WinT = (bf16_t*)((unsigned char*)p.out + DO_WIN);
    bf16_t* WcatT = (bf16_t*)(p.ws + WS_WCAT); bf16_t* WoutT = (bf16_t*)(p.ws + WS_WOUT); bf16_t* WgT = (bf16_t*)(p.ws + WS_WG);
    bf16_t* KB = (bf16_t*)(p.ws + WS_KB); bf16_t* VtB = (bf16_t*)(p.ws + WS_VT); float* agg = (float*)(p.ws + WS_AGG); bf16_t* CG = (bf16_t*)((unsigned char*)p.out + DO_U); float* rss = (float*)(p.ws + WS_RSS); float* rss2 = rss + (size_t)MPAD * 16;

#ifndef DUP_MASK
#define DUP_MASK 0
#endif
    const int nfull = (65 * 34 + 32) % G;
    const bool defer = (nfull != 0) && (G - nfull >= 32);
    if (IN(0)) { p0_prologue(p, lds, vcu * 8 + (tid >> 6), G * 8, 0); if (!defer) p0_prologue(p, lds, vcu * 8 + (tid >> 6), G * 8, 1); }
    SEAM(0);
    if (IN(1)) {
        pg8::Gemm g{U, WinT, D, D}; Sched1 S{G, bx}; Epi1 E{P, p.out + O_PMK, p.out + O_PMV, KB, VtB, p.in[I_SCW]};
        pg8::gemm_phase<Epi1, Sched1>(lds, g, S, E);
        if (defer && bx >= nfull) p0_prologue(p, lds, (bx - nfull) * 8 + (tid >> 6), (G - nfull) * 8, 1);
    }
    SEAM(1);
    if (IN(2)) {
        const bool nost = (p.ph_lo != 0);
        if (DUP_MASK & 0x100) for (int u = bx; u < 256; u += G) attn_prompt_unit(lds, P, KB, VtB, u, nost);
        if (DUP_MASK & 0x200) for (int u = bx; u < 512; u += G) attn_sample_unit(lds, P, p.in[I_CK], p.in[I_CV], u, nost);
        if (DUP_MASK & 0x800) for (int u = bx; u < 256; u += G) sconv_prompt_unit(p, P, u, nost);
        if (UNIT_MASK & 1) for (int u = bx; u < 256; u += G) attn_prompt_unit(lds, P, KB, VtB, u);
        if (UNIT_MASK & 2) attn_sample_phase(lds, P, p.in[I_CK], p.in[I_CV], bx, 512, G);
        if (UNIT_MASK & 4) lru_phase<0>(lds, p, P, WgT, agg, CG, bx, NB * NCH * NLB, G);
        if (UNIT_MASK & 8) lru_phase<2>(lds, p, P, WgT, agg, CG, G - 1 - bx, 24, G);
        if (UNIT_MASK & 16) sconv_fix(p, P, bx, G);
        if (UNIT_MASK & 32) for (int u = bx - 32; u >= 0 && u < 4; u += G) sconv_sample_unit(p, P, u);
    }
    SEAM(2);
    if (IN(3)) {
        sample_g2(lds, P, WcatT, bx, G);
        for (int u = bx; u < 256; u += G) lru_fix_item(lds, p, P, CG, agg, u);
    }
    SEAM(3);
    if (IN(4)) {
        { pg8::Gemm g{P, WcatT, PLD, 2048}; Sched2 S{G, vcu, 0, 256}; Epi2 E{P}; pg8::gemm_phase<Epi2, Sched2>(lds, g, S, E); if (DUP_MASK & 16) pg8::gemm_phase<Epi2, Sched2>(lds, g, S, E); }
        sample_g3(lds, P, WoutT, p.in[I_XS], p.out, rss2, bx, G);
    }
    SEAM(4);
    const bool fused_norm = (G == 256);
    if (IN(5)) {
        pg8::Gemm g{P, WoutT, PLD, D}; Sched3 S{G, vcu, 0, 256};
        if (fused_norm) { Epi3F E{p.in[I_XP], p.out, p.in[I_FNG], (float*)(p.ws + WS_CTL + 65536), (unsigned*)(p.ws + WS_CTL) + 4096, lds}; pg8::gemm_phase<Epi3F, Sched3>(lds, g, S, E); }
        else { Epi3 E{p.in[I_XP], p.in[I_XS], p.out, rss}; pg8::gemm_phase<Epi3, Sched3>(lds, g, S, E); }
    }
    if (!fused_norm) SEAM(5);
    if (IN(6)) {
        const int lane = tid & 63, wave = tid >> 6; const float* fg = p.in[I_FNG];
        for (int m = (fused_norm ? MP : 0) + vcu * 8 + wave; m < MT; m += G * 8) {
            float ss;
            if (m < MP) { const f32x4* rs = (const f32x4*)(rss + (size_t)m * 16); const f32x4 a = rs[0], b2 = rs[1], c2 = rs[2], d2 = rs[3];
                ss = ((a[0] + a[1]) + (a[2] + a[3])) + ((b2[0] + b2[1]) + (b2[2] + b2[3])) + ((c2[0] + c2[1]) + (c2[2] + c2[3])) + ((d2[0] + d2[1]) + (d2[2] + d2[3])); }
            else ss = wave_sum(rss2[(m - MP) * 64 + lane]);
            const float rstd = 1.f / sqrtf(ss * (1.f / D) + EPS);
            f32x4* row = (f32x4*)(p.out + (size_t)m * D) + lane; const f32x4* gr = (const f32x4*)fg + lane;
#pragma unroll
            for (int j = 0; j < 4; ++j) { const f32x4 v = row[64 * j], gg = gr[64 * j]; row[64 * j] = v * rstd * gg; }
        }
    }
#undef IN
#undef SEAM
}

#ifndef MK_N_LAUNCHES
#define MK_N_LAUNCHES 1
#endif
extern "C" void kernel_launch(void* const* d_in, const int* in_sizes, int n_in, void* d_out, int out_size, void* d_ws, size_t ws_size, hipStream_t stream) {
    static int grid = 0;
    if (grid == 0) {
        if (n_in != 26 || out_size != (int)O_END || ws_size < WS_END) { fprintf(stderr, "kernel_launch: unexpected shapes (n_in %d, out %d, ws %zu)\n", n_in, out_size, ws_size); grid = -1; return; }
        int dev = 0, cus = 0, per_cu = 0;
        hipGetDevice(&dev); hipDeviceGetAttribute(&cus, hipDeviceAttributeMultiprocessorCount, dev);
        if (hipFuncSetAttribute((const void*)fwd_kernel, hipFuncAttributeMaxDynamicSharedMemorySize, LDS_BYTES) != hipSuccess) { fprintf(stderr, "kernel_launch: hipFuncSetAttribute failed\n"); grid = -1; return; }
        hipOccupancyMaxActiveBlocksPerMultiprocessor(&per_cu, (const void*)fwd_kernel, 512, LDS_BYTES);
        (void)hipGetLastError();
        if (per_cu < 1) fprintf(stderr, "kernel_launch: occupancy query says %d blocks per CU\n", per_cu);
        grid = cus;
    }
    if (grid < 0) return;
    (void)hipMemsetAsync((char*)d_ws + WS_CTL, 0, 32768, stream);
    Params p{};
    for (int i = 0; i < 26; ++i) p.in[i] = (const float*)d_in[i];
    p.out = (float*)d_out; p.ws = (unsigned char*)d_ws;
#if MK_N_LAUNCHES == 1
    p.ph_lo = 0; p.ph_hi = 7;
    void* args[] = {&p};
    hipError_t e = hipLaunchCooperativeKernel((const void*)fwd_kernel, dim3(grid), dim3(512), args, LDS_BYTES, stream);
    if (e != hipSuccess) fprintf(stderr, "cooperative launch failed: %s (grid %d)\n", hipGetErrorString(e), grid);
#else
    for (int k = 0; k < 7; ++k) { p.ph_lo = k; p.ph_hi = k + 1; hipLaunchKernelGGL(fwd_kernel, dim3(grid), dim3(512), LDS_BYTES, stream, p); }
#endif
}
```

```cpp
#include <hip/hip_runtime.h>
#include <cstdio>
#include <cstdint>

#define LAS __attribute__((address_space(3)))
typedef unsigned short bf16_t;
typedef short bf16x8 __attribute__((ext_vector_type(8)));
typedef float f32x4 __attribute__((ext_vector_type(4)));
typedef float f32x16 __attribute__((ext_vector_type(16)));
typedef unsigned u32x4 __attribute__((ext_vector_type(4)));
typedef unsigned u32x2 __attribute__((ext_vector_type(2)));

constexpr int D = 1024, NB = 8, SEQ = 2048, MP = NB * SEQ, NS = 128, MT = MP + NS, MPAD = 16640;
constexpr int NMEM = 256, MEMROWS = NB * NMEM, UROWS = MPAD + MEMROWS;
constexpr int LW = 768, NLB = 6, LBW = 128, XH = 4, XD = 128, XW = 512, INC = 8704;
constexpr float EPS = 1e-6f;
constexpr int PC_GA = 0, PC_GB = 768, PC_GC = 1536, PC_LX = 2048, PC_CIN = 2816, PC_Q = 3584, PC_G = 4096, PLD = 7168, PC_MRG = 2048;
constexpr int TC = 64, NCH = SEQ / TC;
constexpr size_t O_Y = 0, O_PMK = (size_t)MT * D, O_PMV = O_PMK + (size_t)MEMROWS * XW, O_PH = O_PMV + (size_t)MEMROWS * XW,
                 O_PLC = O_PH + NB * LW, O_PSC = O_PLC + NB * 3 * LW, O_SH = O_PSC + NB * 2 * LW, O_SLC = O_SH + NS * LW, O_SSC = O_SLC + NS * 3 * LW,
                 O_END = O_SSC + NS * 2 * LW;
constexpr size_t MiB = 1u << 20;
constexpr size_t WS_P = 0, WS_WCAT = 228 * MiB, WS_WOUT = 232 * MiB, WS_WG = 234 * MiB, WS_KB = 235 * MiB, WS_VT = 237 * MiB, WS_AGG = 239 * MiB,
                 WS_RSS = 241 * MiB, WS_CTL = 244 * MiB, WS_END = 245 * MiB;
static_assert((size_t)MPAD * PLD * 2 <= WS_WCAT, "P fits");
constexpr size_t DO_U = 0, DO_WIN = 40 * MiB;
static_assert((size_t)UROWS * D * 2 <= DO_WIN && DO_WIN + (size_t)9728 * D * 2 <= (size_t)MP * D * 4, "d_out scratch fits under y_prompt");
constexpr int LDS_BYTES = 147456;

typedef float f32x2_t __attribute__((ext_vector_type(2))); typedef __bf16 bf16x2_t __attribute__((ext_vector_type(2)));
__device__ __forceinline__ unsigned cvt_pk_bf16(float lo, float hi) { const f32x2_t v = {lo, hi}; const bf16x2_t b = __builtin_convertvector(v, bf16x2_t); return __builtin_bit_cast(unsigned, b); }
__device__ __forceinline__ float bflo(unsigned w) { return __uint_as_float(w << 16); }
__device__ __forceinline__ float bfhi(unsigned w) { return __uint_as_float(w & 0xffff0000u); }
__device__ __forceinline__ float bf2f(bf16_t v) { return __uint_as_float(((unsigned)v) << 16); }
__device__ __forceinline__ float sigm(float x) { return __builtin_amdgcn_rcpf(1.f + __expf(-x)); }
__device__ __forceinline__ float silu(float x) { return x * sigm(x); }
__device__ __forceinline__ float wave_sum(float v) {
#pragma unroll
    for (int o = 1; o < 64; o <<= 1) v += __shfl_xor(v, o);
    return v;
}
__device__ __forceinline__ float wave_max(float v) {
#pragma unroll
    for (int o = 1; o < 64; o <<= 1) v = fmaxf(v, __shfl_xor(v, o));
    return v;
}
__device__ __forceinline__ void unpack8(const u32x4 w, float* f) {
    f[0] = bflo(w.x); f[1] = bfhi(w.x); f[2] = bflo(w.y); f[3] = bfhi(w.y); f[4] = bflo(w.z); f[5] = bfhi(w.z); f[6] = bflo(w.w); f[7] = bfhi(w.w);
}
__device__ __forceinline__ u32x4 pack8(const float* f) {
    u32x4 w; w.x = cvt_pk_bf16(f[0], f[1]); w.y = cvt_pk_bf16(f[2], f[3]); w.z = cvt_pk_bf16(f[4], f[5]); w.w = cvt_pk_bf16(f[6], f[7]); return w;
}

namespace pg8 {
constexpr int BM = 256, BK = 64, HALF = 128, HTB = HALF * BK * 2, STAGE_BYTES = 8 * HTB, NXCD = 8, WGM = 8;
__host__ __device__ __forceinline__ int lds_byte(int r, int c) { const int st = (r >> 4) * 2 + (c >> 5), rr = r & 15, cc = c & 31, ob = rr * 64 + cc * 2; return st * 1024 + (ob ^ (((ob >> 9) & 1) << 5)); }
__host__ __device__ __forceinline__ void stage_rc(int b, int& R, int& C) { const int st = b / 1024, sb = b % 1024, swz = sb ^ (((sb >> 9) & 1) << 5); R = (st >> 1) * 16 + swz / 64; C = (st & 1) * 32 + (swz % 64) / 2; }
__host__ __device__ __forceinline__ int perm32(int rho) { const int n = rho >> 4, i = rho & 15; return 8 * (i >> 2) + 4 * n + (i & 3); }

struct Unit { int pm, pn, seg; };
struct Gemm { const bf16_t* A; const bf16_t* Bt; int lda, ldb; };

template <class Epi, class Sched>
__device__ __forceinline__ void gemm_phase(LAS unsigned char* lds, const Gemm g, const Sched& S, const Epi& E) {
    const int tid = threadIdx.x, wid = __builtin_amdgcn_readfirstlane(tid >> 6), lane = tid & 63, wr = wid >> 2, wc = wid & 3, fr = lane & 15, fq = lane >> 4;
    unsigned voffA[2], voffB[2];
#pragma unroll
    for (int i = 0; i < 2; ++i) { int R, C; stage_rc(tid * 16 + i * 8192, R, C); const int Rb = Epi::PERM ? ((R & ~31) + perm32(R & 31)) : R;
        voffA[i] = (unsigned)(R * g.lda + C) * 2u; voffB[i] = (unsigned)(Rb * g.ldb + C) * 2u; }
    const size_t kstep = (size_t)(BK * 2);
    const size_t hstepA = (size_t)HALF * g.lda * 2, hstepB = (size_t)HALF * g.ldb * 2;
    const unsigned ldsw = (unsigned)wid * 1024u;
    const int aoff = lds_byte(wr * 64 + fr, fq * 8), boff = lds_byte(wc * 32 + fr, fq * 8);
#define PG8_SA(b, h) (((b) * 2 + (h)) * HTB)
#define PG8_SB(b, h) ((4 + (b) * 2 + (h)) * HTB)
#define PG8_STAGE(bufoff, gbase, voff) do { _Pragma("unroll") for (int _i = 0; _i < 2; ++_i) \
        __builtin_amdgcn_global_load_lds((const unsigned*)((const char*)(gbase) + (voff)[_i]), (LAS unsigned*)(lds + (bufoff) + ldsw + _i * 8192), 16, 0, 0); } while (0)
#define PG8_LDA(dst, b, h) do { _Pragma("unroll") for (int m = 0; m < 4; ++m) _Pragma("unroll") for (int k = 0; k < 2; ++k) dst[m][k] = *(const LAS bf16x8*)(lds + PG8_SA(b, h) + aoff + m * 2048 + k * 1024); } while (0)
#define PG8_LDB(dst, b, h) do { _Pragma("unroll") for (int n = 0; n < 2; ++n) _Pragma("unroll") for (int k = 0; k < 2; ++k) dst[n][k] = *(const LAS bf16x8*)(lds + PG8_SB(b, h) + boff + n * 2048 + k * 1024); } while (0)
#define PG8_MMA(ai, bj, At, Bt) do { __builtin_amdgcn_s_setprio(1); _Pragma("unroll") for (int m = 0; m < 4; ++m) _Pragma("unroll") for (int n = 0; n < 2; ++n) _Pragma("unroll") for (int k = 0; k < 2; ++k) \
        acc[ai][bj][m][n] = __builtin_amdgcn_mfma_f32_16x16x32_bf16(Bt[n][k], At[m][k], acc[ai][bj][m][n], 0, 0, 0); __builtin_amdgcn_s_setprio(0); } while (0)
#define PG8_WAIT_V(n) asm volatile("s_waitcnt vmcnt(" #n ")" ::: "memory")
#define PG8_WAIT_L(n) asm volatile("s_waitcnt lgkmcnt(" #n ")" ::: "memory")
#define PG8_BAR __builtin_amdgcn_s_barrier()
#define PG8_SCHED __builtin_amdgcn_sched_barrier(0)
    Unit cur, nxt; int ui = 0;
    if (!S.next(0, cur)) return;
    f32x4 acc[2][2][4][2];
#pragma unroll
    for (int a = 0; a < 2; ++a)
#pragma unroll
        for (int b = 0; b < 2; ++b)
#pragma unroll
            for (int m = 0; m < 4; ++m)
#pragma unroll
                for (int n = 0; n < 2; ++n) acc[a][b][m][n] = (f32x4){0.f, 0.f, 0.f, 0.f};
    bf16x8 At[4][2], B0[2][2], B1[2][2];
    const char* cA = (const char*)g.A + S.a_off(cur); const char* cB = (const char*)g.Bt + S.b_off(cur);
    int nt = S.nt(cur);
    PG8_STAGE(PG8_SB(0, 0), cB, voffB); PG8_STAGE(PG8_SB(0, 1), cB + hstepB, voffB); PG8_STAGE(PG8_SA(0, 0), cA, voffA); PG8_STAGE(PG8_SA(0, 1), cA + hstepA, voffA);
    if (wr == 1) PG8_BAR;
    PG8_WAIT_V(2); PG8_BAR;
    PG8_STAGE(PG8_SB(1, 0), cB + kstep, voffB); PG8_STAGE(PG8_SA(1, 0), cA + kstep, voffA); PG8_STAGE(PG8_SB(1, 1), cB + hstepB + kstep, voffB);
    PG8_WAIT_V(6); PG8_BAR;
    for (;;) {
        const bool has_next = S.next(ui + 1, nxt);
        const char* nA = has_next ? (const char*)g.A + S.a_off(nxt) : cA; const char* nB = has_next ? (const char*)g.Bt + S.b_off(nxt) : cB;
        for (int t = 0; t < nt; t += 2) {
            const bool last = (t == nt - 2);
            const char* a1 = cA + (size_t)(t + 1) * kstep;
            const char* a2 = last ? nA : cA + (size_t)(t + 2) * kstep; const char* b2 = last ? nB : cB + (size_t)(t + 2) * kstep;
            const char* a3 = a2 + kstep; const char* b3 = b2 + kstep;
            PG8_LDB(B0, 0, 0); PG8_LDB(B1, 0, 1); PG8_SCHED; PG8_LDA(At, 0, 0); PG8_STAGE(PG8_SA(1, 1), a1 + hstepA, voffA);
            PG8_WAIT_V(8); PG8_WAIT_L(0); PG8_BAR; PG8_MMA(0, 0, At, B0); PG8_MMA(0, 1, At, B1); PG8_BAR; PG8_SCHED;
            PG8_LDA(At, 0, 1); PG8_STAGE(PG8_SB(0, 0), b2, voffB); PG8_STAGE(PG8_SB(0, 1), b2 + hstepB, voffB); PG8_STAGE(PG8_SA(0, 0), a2, voffA);
            PG8_WAIT_V(8); PG8_WAIT_L(0); PG8_BAR; PG8_MMA(1, 0, At, B0); PG8_MMA(1, 1, At, B1); PG8_BAR; PG8_SCHED;
            PG8_LDB(B0, 1, 0); PG8_LDB(B1, 1, 1); PG8_SCHED; PG8_LDA(At, 1, 0); PG8_STAGE(PG8_SA(0, 1), a2 + hstepA, voffA);
            PG8_WAIT_V(8); PG8_WAIT_L(0); PG8_BAR; PG8_MMA(0, 0, At, B0); PG8_MMA(0, 1, At, B1); PG8_BAR; PG8_SCHED;
            PG8_LDA(At, 1, 1); PG8_STAGE(PG8_SB(1, 0), b3, voffB); PG8_STAGE(PG8_SB(1, 1), b3 + hstepB, voffB); PG8_STAGE(PG8_SA(1, 0), a3, voffA);
            PG8_WAIT_V(8); PG8_WAIT_L(0); PG8_BAR; PG8_MMA(1, 0, At, B0); PG8_MMA(1, 1, At, B1); PG8_BAR; PG8_SCHED;
        }
        if (wr == 0) PG8_BAR;
        const bool keep = E(acc, cur, wr, wc, fr, fq);
        if (!has_next) break;
        if (!keep) {
#pragma unroll
            for (int a = 0; a < 2; ++a)
#pragma unroll
                for (int b = 0; b < 2; ++b)
#pragma unroll
                    for (int m = 0; m < 4; ++m)
#pragma unroll
                        for (int n = 0; n < 2; ++n) acc[a][b][m][n] = (f32x4){0.f, 0.f, 0.f, 0.f};
        }
        cur = nxt; cA = nA; cB = nB; nt = S.nt(cur); ++ui;
        if (wr == 1) PG8_BAR;
    }
    PG8_WAIT_V(0);
    PG8_BAR;
#undef PG8_SA
#undef PG8_SB
#undef PG8_STAGE
#undef PG8_LDA
#undef PG8_LDB
#undef PG8_MMA
#undef PG8_WAIT_V
#undef PG8_WAIT_L
#undef PG8_BAR
#undef PG8_SCHED
}
}
using pg8::Unit;

#define XB_TMO      128
#define XB_XCNT(j)  (256  + 64 * (j))
#define XB_XSUB(j)  (1280 + 64 * (j))
#define XB_XGEN(j)  (2304 + 64 * (j))
#define XB_TOP      3328
#define XB_TOPGEN   3392
#define XCD_BAR_WORDS 3456
#define XB_SPIN_CAP (1u << 18)
__device__ __forceinline__ unsigned xb_ld(unsigned* p)              { return __hip_atomic_load(p, __ATOMIC_RELAXED, __HIP_MEMORY_SCOPE_AGENT); }
__device__ __forceinline__ unsigned xb_add(unsigned* p, unsigned v) { return __hip_atomic_fetch_add(p, v, __ATOMIC_RELAXED, __HIP_MEMORY_SCOPE_AGENT); }
__device__ __forceinline__ unsigned xb_xcc_id() { return (unsigned)__builtin_amdgcn_s_getreg((3 << 11) | 20) & 0xFu; }
#define XB_SPIN(cond, bar) do { unsigned _sp = 0; while (cond) { __builtin_amdgcn_s_sleep(1); \
    if ((++_sp & 255u) == 0u) { if (xb_ld(&(bar)[XB_TMO])) break; if (_sp > XB_SPIN_CAP) { atomicAdd(&(bar)[XB_TMO], 1u); break; } } } } while (0)
struct XcdBarrier { unsigned* bar; unsigned x; volatile LAS unsigned* st; };
__device__ __forceinline__ XcdBarrier xcd_barrier_post(unsigned* bar, volatile LAS unsigned* st) {
    XcdBarrier b; b.bar = bar; b.x = xb_xcc_id(); b.st = st;
    if (threadIdx.x == 0) (void)xb_add(&bar[XB_XCNT(b.x)], 1u);
    return b;
}
__device__ __forceinline__ void xcd_barrier_complete(unsigned* bar, unsigned x, unsigned& nloc, unsigned& nx) {
    const unsigned G = gridDim.x * gridDim.y * gridDim.z;
    unsigned sum, cnt, mine, sp = 0u;
    for (;;) {
        sum = 0u; cnt = 0u; mine = 0u;
#pragma unroll
        for (unsigned j = 0; j < 16; ++j) { const unsigned c = xb_ld(&bar[XB_XCNT(j)]); sum += c; cnt += (c > 0u) ? 1u : 0u; mine = (j == x) ? c : mine; }
        if (sum == G) break;
        __builtin_amdgcn_s_sleep(1);
        if ((++sp & 255u) == 0u) { if (xb_ld(&bar[XB_TMO])) break; if (sp > XB_SPIN_CAP) { atomicAdd(&bar[XB_TMO], 1u); break; } }
    }
    nloc = mine > 0u ? mine : 1u; nx = cnt > 0u ? cnt : 1u;
}
__device__ __forceinline__ void xcd_barrier(const XcdBarrier& b) {
    asm volatile("s_waitcnt vmcnt(0)" ::: "memory");
    __syncthreads();
    if (threadIdx.x == 0) {
        unsigned* bar = b.bar;
        __builtin_amdgcn_s_waitcnt(0);
        unsigned nloc = b.st[0], nx = b.st[1];
        if (nloc == 0u) { xcd_barrier_complete(bar, b.x, nloc, nx); b.st[0] = nloc; b.st[1] = nx; }
        const unsigned old = xb_add(&bar[XB_XSUB(b.x)], 1u);
        const unsigned gen = old / nloc;
        if (old + 1u == (gen + 1u) * nloc) {
            __builtin_amdgcn_fence(__ATOMIC_RELEASE, "agent");
            asm volatile("s_waitcnt vmcnt(0)" ::: "memory");
            const unsigned og = xb_add(&bar[XB_TOP], 1u);
            const unsigned tg = og / nx;
            if (og + 1u == (tg + 1u) * nx) xb_add(&bar[XB_TOPGEN], 1u);
            else XB_SPIN(xb_ld(&bar[XB_TOPGEN]) == tg, bar);
            __builtin_amdgcn_fence(__ATOMIC_ACQUIRE, "agent");
            xb_add(&bar[XB_XGEN(b.x)], 1u);
            asm volatile("s_waitcnt vmcnt(0)" ::: "memory");
        } else {
            XB_SPIN(xb_ld(&bar[XB_XGEN(b.x)]) == gen, bar);
            __builtin_amdgcn_fence(__ATOMIC_ACQUIRE, "agent");
            asm volatile("s_waitcnt vmcnt(0)" ::: "memory");
        }
    }
    __syncthreads();
}

struct Params { const float* in[26]; float* out; unsigned char* ws; int ph_lo, ph_hi; };
enum { I_XP = 0, I_XS, I_CK, I_CV, I_SH, I_SLC, I_SSC, I_MEM, I_NG, I_MNG, I_WIN, I_CW, I_CB, I_WA, I_BA, I_WX, I_BX, I_LAM, I_LWO, I_SCW, I_SWO, I_WK, I_WV, I_XWO, I_WOUT, I_FNG };

__device__ __forceinline__ int win_dst_row(int s) {
    if (s < 1536 || s >= 4608) { const int c = s & 255;
        return (s & ~255) + 128 * ((c >> 5) & 1) + 32 * (c >> 6) + (c & 31); }
    const int q = s - 1536, seg = q / 768, ch = q - seg * 768;
    return 1536 + 256 * (ch >> 6) + 128 * (seg >> 1) + 32 * ((ch & 63) >> 4) + 8 * ((ch & 15) >> 2) + 4 * (seg & 1) + (ch & 3);
}
template <int MAP>
__device__ __forceinline__ void transpose_item(const float* W, int ldw, int k0, int s0, bf16_t* WT, int ldo, int rowoff, int coloff, LAS float* scr, int lane) {
    { f32x4 v[8];
#pragma unroll
        for (int i = 0; i < 8; ++i) v[i] = __builtin_nontemporal_load((const f32x4*)(W + (size_t)(k0 + 8 * i + (lane >> 3)) * ldw + s0 + 4 * (lane & 7)));
#pragma unroll
        for (int i = 0; i < 8; ++i) { LAS float* d = scr + (8 * i + (lane >> 3)) * 33 + 4 * (lane & 7); d[0] = v[i][0]; d[1] = v[i][1]; d[2] = v[i][2]; d[3] = v[i][3]; } }
    asm volatile("s_waitcnt lgkmcnt(0)" ::: "memory");
    const int c = lane & 7;
#pragma unroll
    for (int j = 0; j < 4; ++j) { const int n = (lane >> 3) + 8 * j; const LAS float* s = scr + (8 * c) * 33 + n;
        u32x4 o; o.x = cvt_pk_bf16(s[0 * 33], s[1 * 33]); o.y = cvt_pk_bf16(s[2 * 33], s[3 * 33]); o.z = cvt_pk_bf16(s[4 * 33], s[5 * 33]); o.w = cvt_pk_bf16(s[6 * 33], s[7 * 33]);
        const int drow = MAP ? win_dst_row(s0 + n) : (rowoff + s0 + n);
        *(u32x4*)(WT + (size_t)drow * ldo + coloff + k0 + 8 * c) = o; }
    asm volatile("s_waitcnt lgkmcnt(0)" ::: "memory");
}
__device__ __forceinline__ void rms_row(const float* xrow, const float* g, bf16_t* orow, int lane) {
    const f32x4* xr = (const f32x4*)xrow + lane; const f32x4* gr = (const f32x4*)g + lane;
    f32x4 v[4]; float s = 0.f;
#pragma unroll
    for (int j = 0; j < 4; ++j) { v[j] = xr[64 * j]; s += (v[j].x * v[j].x + v[j].y * v[j].y) + (v[j].z * v[j].z + v[j].w * v[j].w); }
    const float rstd = 1.f / sqrtf(wave_sum(s) * (1.f / D) + EPS);
    u32x2* o8 = (u32x2*)orow + lane;
#pragma unroll
    for (int j = 0; j < 4; ++j) { const f32x4 gg = gr[64 * j]; u32x2 w; w.x = cvt_pk_bf16(v[j].x * rstd * gg.x, v[j].y * rstd * gg.y); w.y = cvt_pk_bf16(v[j].z * rstd * gg.z, v[j].w * rstd * gg.w); o8[64 * j] = w; }
}
__device__ __forceinline__ void p0_prologue(const Params& p, LAS unsigned char* lds, int gw, int NGW, int part) {
    const int tid = threadIdx.x, lane = tid & 63, wave = tid >> 6;
    LAS float* scr = (LAS float*)(lds + wave * 16384);
    bf16_t* WinT = (bf16_t*)((unsigned char*)p.out + DO_WIN); bf16_t* U = (bf16_t*)((unsigned char*)p.out + DO_U);
    bf16_t* WcatT = (bf16_t*)(p.ws + WS_WCAT); bf16_t* WoutT = (bf16_t*)(p.ws + WS_WOUT); bf16_t* WgT = (bf16_t*)(p.ws + WS_WG);
    constexpr int N0 = 16 * 272, N1 = 16 * 16, N3 = 12 * 32, N5 = 8 * 32, N6 = 16 * 32, N7 = 6 * 8;
    constexpr int NITEMS = N0 + 2 * N1 + 2 * N3 + N5 + N6 + 2 * N7, NSPLIT = N0 + 2 * N1;
    for (int it = (part ? NSPLIT : 0) + (NGW - 1 - gw); it < (part ? NITEMS : NSPLIT); it += NGW) {
        int r = it;
        if (r < N0) { transpose_item<1>(p.in[I_WIN], INC, 64 * (r / 272), 32 * (r % 272), WinT, D, 0, 0, scr, lane); continue; } r -= N0;
        if (r < N1) { transpose_item<0>(p.in[I_WK], XW, 64 * (r / 16), 32 * (r % 16), WinT, D, 8704, 0, scr, lane); continue; } r -= N1;
        if (r < N1) { transpose_item<0>(p.in[I_WV], XW, 64 * (r / 16), 32 * (r % 16), WinT, D, 9216, 0, scr, lane); continue; } r -= N1;
        if (r < N3) { transpose_item<0>(p.in[I_LWO], D, 64 * (r / 32), 32 * (r % 32), WcatT, 2048, 0, 0, scr, lane); continue; } r -= N3;
        if (r < N3) { transpose_item<0>(p.in[I_SWO], D, 64 * (r / 32), 32 * (r % 32), WcatT, 2048, 0, 768, scr, lane); continue; } r -= N3;
        if (r < N5) { transpose_item<0>(p.in[I_XWO], D, 64 * (r / 32), 32 * (r % 32), WcatT, 2048, 0, 1536, scr, lane); continue; } r -= N5;
        if (r < N6) { transpose_item<0>(p.in[I_WOUT], D, 64 * (r / 32), 32 * (r % 32), WoutT, D, 0, 0, scr, lane); continue; } r -= N6;
        if (r < N7) { const int blk = r / 8, q = r % 8; transpose_item<0>(p.in[I_WA] + (size_t)blk * 128 * 128, 128, 64 * (q / 4), 32 * (q % 4), WgT, 128, blk * 256, 0, scr, lane); continue; } r -= N7;
        { const int blk = r / 8, q = r % 8; transpose_item<0>(p.in[I_WX] + (size_t)blk * 128 * 128, 128, 64 * (q / 4), 32 * (q % 4), WgT, 128, blk * 256 + 128, 0, scr, lane); }
    }
    if (part) return;
    if (gw < 12) {
        const int ch = gw * 64 + lane; const float lam = p.in[I_LAM][ch];
        ((float*)(p.ws + WS_WG + 524288))[ch] = -8.0f * ((lam > 15.f) ? __expf(-lam) : log1pf(__expf(-lam))); }
    for (int m = gw; m < UROWS; m += NGW) {
        bf16_t* orow = U + (size_t)m * D;
        if (m < MP) rms_row(p.in[I_XP] + (size_t)m * D, p.in[I_NG], orow, lane);
        else if (m < MT) rms_row(p.in[I_XS] + (size_t)(m - MP) * D, p.in[I_NG], orow, lane);
        else if (m < MPAD) { u32x2* o8 = (u32x2*)orow + lane;
#pragma unroll
            for (int j = 0; j < 4; ++j) o8[64 * j] = (u32x2){0u, 0u}; }
        else rms_row(p.in[I_MEM] + (size_t)(m - MPAD) * D, p.in[I_MNG], orow, lane);
    }
}

struct Sched1 {
    int G, c;
    __device__ __forceinline__ bool next(int i, Unit& u) const {
        const int L = i * G + c; constexpr int nM = 65, nN = 34, nwg = nM * nN;
        if (L >= nwg + 32) return false;
        u.seg = 0;
        if (L < 32) { u.pm = 65 + (L >> 2); u.pn = 34 + (L & 3); return true; }
        int wgid = L - 32; { const int q = nwg / 8, r = nwg % 8, xcd = wgid % 8, off = wgid / 8; wgid = (xcd < r ? xcd * (q + 1) : r * (q + 1) + (xcd - r) * q) + off; }
        const int nig = 8 * nN, gid = wgid / nig, fm = gid * 8, gsz = (nM - fm) < 8 ? (nM - fm) : 8;
        u.pm = fm + ((wgid % nig) % gsz); u.pn = (wgid % nig) / gsz; return true;
    }
    __device__ __forceinline__ size_t a_off(const Unit& u) const { return (size_t)u.pm * 256 * D * 2; }
    __device__ __forceinline__ size_t b_off(const Unit& u) const { return (size_t)u.pn * 256 * D * 2; }
    __device__ __forceinline__ int nt(const Unit&) const { return D / 64; }
};
constexpr float QSCALE = 0.08838834764831845f * 1.4426950408889634f;
__device__ __forceinline__ int vt_pos(int m) { const int kl = m & 15; return (m & ~15) + 8 * ((kl >> 2) & 1) + 4 * (kl >> 3) + (kl & 3); }
struct Epi1 {
    static constexpr bool PERM = true;
    bf16_t* P; float* outK; float* outV; bf16_t* KB; bf16_t* VtB; const float* scw;
    __device__ __forceinline__ bool operator()(f32x4 (&acc)[2][2][4][2], const Unit& u, int wr, int wc, int fr, int fq) const {
        const int pn = u.pn; const int row0 = u.pm * 256 + wr * 64 + fr;
        if (pn >= 34) {
            const int mr0 = row0 - MPAD; const bool isV = pn >= 36;
#pragma unroll
            for (int ai = 0; ai < 2; ++ai)
#pragma unroll
                for (int m = 0; m < 4; ++m) { const int mr = mr0 + ai * 128 + m * 16;
#pragma unroll
                    for (int bj = 0; bj < 2; ++bj) { const int col = (pn - (isV ? 36 : 34)) * 256 + bj * 128 + wc * 32 + 8 * fq; const f32x4 v0 = acc[ai][bj][m][0], v1 = acc[ai][bj][m][1];
                        float* o = (isV ? outV : outK) + (size_t)mr * XW + col; *(f32x4*)o = v0; *(f32x4*)(o + 4) = v1;
                        if (!isV) { u32x4 w; w.x = cvt_pk_bf16(v0[0], v0[1]); w.y = cvt_pk_bf16(v0[2], v0[3]); w.z = cvt_pk_bf16(v1[0], v1[1]); w.w = cvt_pk_bf16(v1[2], v1[3]); *(u32x4*)(KB + (size_t)mr * XW + col) = w; }
                        else { const int b = mr >> 8, mm = mr & 255, h = col >> 7, d0 = col & 127; bf16_t* vt = VtB + ((size_t)(b * 4 + h) * 128 + d0) * 256 + vt_pos(mm);
                            const unsigned w0 = cvt_pk_bf16(v0[0], v0[1]), w1 = cvt_pk_bf16(v0[2], v0[3]), w2 = cvt_pk_bf16(v1[0], v1[1]), w3 = cvt_pk_bf16(v1[2], v1[3]);
                            vt[0] = (bf16_t)w0; vt[256] = (bf16_t)(w0 >> 16); vt[512] = (bf16_t)w1; vt[768] = (bf16_t)(w1 >> 16); vt[1024] = (bf16_t)w2; vt[1280] = (bf16_t)(w2 >> 16); vt[1536] = (bf16_t)w3; vt[1792] = (bf16_t)(w3 >> 16); } } }
            return false;
        }
        if (pn >= 6 && pn < 18) {
            const int ch0 = 64 * (pn - 6) + 16 * wc + 4 * fq;
            if (u.pm >= 64) {
#pragma unroll
                for (int ai = 0; ai < 2; ++ai)
#pragma unroll
                    for (int m = 0; m < 4; ++m) { const f32x4 sb = acc[ai][0][m][0], scg = acc[ai][0][m][1], sh = acc[ai][1][m][0], sg = acc[ai][1][m][1];
                        bf16_t* prow = P + (size_t)(row0 + ai * 128 + m * 16) * PLD;
                        u32x2 wc_, wg_;
                        wc_.x = cvt_pk_bf16(scg[0] * sh[0], scg[1] * sh[1]); wc_.y = cvt_pk_bf16(scg[2] * sh[2], scg[3] * sh[3]);
                        wg_.x = cvt_pk_bf16(silu(sg[0]) * sb[0], silu(sg[1]) * sb[1]); wg_.y = cvt_pk_bf16(silu(sg[2]) * sb[2], silu(sg[3]) * sb[3]);
                        *(u32x2*)(prow + PC_CIN + ch0) = wc_; *(u32x2*)(prow + PC_GB + ch0) = wg_; }
                return false;
            }
            const f32x4 w0 = *(const f32x4*)(scw + ch0), w1 = *(const f32x4*)(scw + LW + ch0), w2 = *(const f32x4*)(scw + 2 * LW + ch0);
#pragma unroll
            for (int ai = 0; ai < 2; ++ai) {
                f32x4 cprev = (f32x4){0.f, 0.f, 0.f, 0.f};
#pragma unroll
                for (int m = 0; m < 4; ++m) { const f32x4 sb = acc[ai][0][m][0], scg = acc[ai][0][m][1], sh = acc[ai][1][m][0], sg = acc[ai][1][m][1];
                    bf16_t* prow = P + (size_t)(row0 + ai * 128 + m * 16) * PLD;
                    const f32x4 cin = scg * sh; f32x4 gp, c1, c2;
#pragma unroll
                    for (int i = 0; i < 4; ++i) { gp[i] = silu(sg[i]) * sb[i];
                        const float v1 = (fr == 15) ? cprev[i] : cin[i], v2 = (fr >= 14) ? cprev[i] : cin[i];
                        c1[i] = __int_as_float(__builtin_amdgcn_update_dpp(0, __float_as_int(v1), 0x121, 0xf, 0xf, false));
                        c2[i] = __int_as_float(__builtin_amdgcn_update_dpp(0, __float_as_int(v2), 0x122, 0xf, 0xf, false)); }
                    const bool special = (m == 0 && fr < 2);
                    const f32x4 gb = gp * (w0 * c2 + w1 * c1 + w2 * cin);
                    const f32x4 o = special ? gp : gb;
                    u32x2 wg_; wg_.x = cvt_pk_bf16(o[0], o[1]); wg_.y = cvt_pk_bf16(o[2], o[3]);
                    *(u32x2*)(prow + PC_GB + ch0) = wg_;
                    if (special || (m == 3 && fr >= 14)) { u32x2 wc_; wc_.x = cvt_pk_bf16(cin[0], cin[1]); wc_.y = cvt_pk_bf16(cin[2], cin[3]); *(u32x2*)(prow + PC_CIN + ch0) = wc_; }
                    cprev = cin; }
            }
            return false;
        }
        int mode, dcol;
        if (pn < 3) { mode = 0; dcol = PC_LX + 256 * pn; }
        else if (pn < 6) { mode = 1; dcol = PC_GA + 256 * (pn - 3); }
        else if (pn < 20) { mode = 2; dcol = PC_Q + 256 * (pn - 18); }
        else if (pn < 22) { mode = 1; dcol = PC_GC + 256 * (pn - 20); }
        else { mode = 3; dcol = PC_G + 256 * (pn - 22); }
#define EPI1_STORE_LOOP(XF) do { _Pragma("unroll") for (int ai = 0; ai < 2; ++ai) _Pragma("unroll") for (int m = 0; m < 4; ++m) { \
            bf16_t* prow = P + (size_t)(row0 + ai * 128 + m * 16) * PLD + dcol + wc * 64 + 8 * fq; \
            _Pragma("unroll") for (int bj = 0; bj < 2; ++bj) { f32x4 v0 = acc[ai][bj][m][0], v1 = acc[ai][bj][m][1]; \
                _Pragma("unroll") for (int i = 0; i < 4; ++i) { v0[i] = XF(v0[i]); v1[i] = XF(v1[i]); } \
                u32x4 w; w.x = cvt_pk_bf16(v0[0], v0[1]); w.y = cvt_pk_bf16(v0[2], v0[3]); w.z = cvt_pk_bf16(v1[0], v1[1]); w.w = cvt_pk_bf16(v1[2], v1[3]); \
                *(u32x4*)(prow + bj * 32) = w; } } } while (0)
#define EPI1_ID(x) (x)
#define EPI1_SC(x) ((x) * QSCALE)
        if (mode == 0) EPI1_STORE_LOOP(EPI1_ID); else if (mode == 1) EPI1_STORE_LOOP(silu); else if (mode == 2) EPI1_STORE_LOOP(EPI1_SC); else EPI1_STORE_LOOP(sigm);
#undef EPI1_STORE_LOOP
#undef EPI1_ID
#undef EPI1_SC
        return false;
    }
};

struct Sched2 {
    int G, c, su0, su1;
    __device__ __forceinline__ bool next(int i, Unit& u) const {
        const int su = su0 + c + (i / 3) * G; if (su >= su1) return false;
        u.pm = su >> 2; u.pn = su & 3; u.seg = i % 3; return true;
    }
    __device__ __forceinline__ size_t a_off(const Unit& u) const { return ((size_t)u.pm * 256 * PLD + u.seg * 768) * 2; }
    __device__ __forceinline__ size_t b_off(const Unit& u) const { return ((size_t)u.pn * 256 * 2048 + u.seg * 768) * 2; }
    __device__ __forceinline__ int nt(const Unit& u) const { return u.seg < 2 ? 12 : 8; }
};
struct Epi2 {
    static constexpr bool PERM = true;
    bf16_t* P;
    __device__ __forceinline__ bool operator()(f32x4 (&acc)[2][2][4][2], const Unit& u, int wr, int wc, int fr, int fq) const {
        const int row0 = u.pm * 256 + wr * 64 + fr, col0 = u.pn * 256 + wc * 32 + 8 * fq, seg = u.seg;
#pragma unroll
        for (int ai = 0; ai < 2; ++ai) {
            u32x4 nw[4][2], dw[4][2];
#pragma unroll
            for (int m = 0; m < 4; ++m) { const bf16_t* prow = P + (size_t)(row0 + ai * 128 + m * 16) * PLD + PC_G + seg * 1024 + col0;
#pragma unroll
                for (int bj = 0; bj < 2; ++bj) { nw[m][bj] = *(const u32x4*)(prow + bj * 128); if (seg < 2) dw[m][bj] = *(const u32x4*)(prow + 1024 + bj * 128); } }
#pragma unroll
            for (int m = 0; m < 4; ++m) { bf16_t* prow = P + (size_t)(row0 + ai * 128 + m * 16) * PLD;
#pragma unroll
                for (int bj = 0; bj < 2; ++bj) { const int col = col0 + bj * 128;
                    float num[8], den[8];
                    unpack8(nw[m][bj], num);
                    if (seg < 2) { unpack8(dw[m][bj], den);
#pragma unroll
                        for (int i = 0; i < 8; ++i) num[i] = num[i] * __builtin_amdgcn_rcpf(den[i]); }
                    f32x4 v0 = acc[ai][bj][m][0], v1 = acc[ai][bj][m][1];
#pragma unroll
                    for (int i = 0; i < 4; ++i) { v0[i] *= num[i]; v1[i] *= num[4 + i]; }
                    if (seg < 2) { acc[ai][bj][m][0] = v0; acc[ai][bj][m][1] = v1; }
                    else { u32x4 w; w.x = cvt_pk_bf16(v0[0], v0[1]); w.y = cvt_pk_bf16(v0[2], v0[3]); w.z = cvt_pk_bf16(v1[0], v1[1]); w.w = cvt_pk_bf16(v1[2], v1[3]);
                        *(u32x4*)(prow + PC_MRG + col) = w; } } }
            asm volatile("" ::: "memory"); }
        return seg < 2;
    }
};
struct Sched3 {
    int G, c, su0, su1;
    __device__ __forceinline__ bool next(int i, Unit& u) const { const int su = su0 + c + i * G; if (su >= su1) return false; u.pm = su >> 2; u.pn = su & 3; u.seg = 0; return true; }
    __device__ __forceinline__ size_t a_off(const Unit& u) const { return ((size_t)u.pm * 256 * PLD + PC_MRG) * 2; }
    __device__ __forceinline__ size_t b_off(const Unit& u) const { return (size_t)u.pn * 256 * D * 2; }
    __device__ __forceinline__ int nt(const Unit&) const { return D / 64; }
};
struct Epi3 {
    static constexpr bool PERM = false;
    const float* xp; const float* xs; float* out; float* rss;
    __device__ __forceinline__ bool operator()(f32x4 (&acc)[2][2][4][2], const Unit& u, int wr, int wc, int fr, int fq) const {
        const int row0 = u.pm * 256 + wr * 64 + fr, col0 = u.pn * 256 + wc * 32 + 4 * fq;
#pragma unroll
        for (int ai = 0; ai < 2; ++ai)
#pragma unroll
            for (int mp = 0; mp < 2; ++mp) {
                f32x4 xv[2][2][2];
#pragma unroll
                for (int mm = 0; mm < 2; ++mm) { const int row = row0 + ai * 128 + (2 * mp + mm) * 16; const bool ok = row < MT;
                    const float* xrow = (row < MP ? xp + (size_t)row * D : xs + (size_t)((ok ? row : MP) - MP) * D) + col0;
#pragma unroll
                    for (int bj = 0; bj < 2; ++bj)
#pragma unroll
                        for (int n = 0; n < 2; ++n) xv[mm][bj][n] = *(const f32x4*)(xrow + bj * 128 + n * 16); }
#pragma unroll
                for (int mm = 0; mm < 2; ++mm) { const int m = 2 * mp + mm; const int row = row0 + ai * 128 + m * 16; const bool ok = row < MT; float ss = 0.f;
                    float* orow = out + (size_t)row * D + col0;
#pragma unroll
                    for (int bj = 0; bj < 2; ++bj)
#pragma unroll
                        for (int n = 0; n < 2; ++n) { const f32x4 v = xv[mm][bj][n] + acc[ai][bj][m][n];
                            if (ok) *(f32x4*)(orow + bj * 128 + n * 16) = v; ss += (v[0] * v[0] + v[1] * v[1]) + (v[2] * v[2] + v[3] * v[3]); }
                    ss += __shfl_xor(ss, 16); ss += __shfl_xor(ss, 32);
                    if (ok && fq == 0) rss[(size_t)row * 16 + u.pn * 4 + wc] = ss; }
                asm volatile("" ::: "memory"); }
        return false;
    }
};

struct Epi3F {
    static constexpr bool PERM = false;
    const float* xp; float* out; const float* fg; float* xbuf; unsigned* cnt; LAS unsigned char* lds;
    __device__ __forceinline__ bool operator()(f32x4 (&acc)[2][2][4][2], const Unit& u, int wr, int wc, int fr, int fq) const {
        const int tid = threadIdx.x, lane = tid & 63, wid = tid >> 6;
        LAS float* PT = (LAS float*)(lds + 131072); LAS float* ST = PT + 1024;
        const int row0 = u.pm * 256 + wr * 64 + fr, col0 = u.pn * 256 + wc * 32 + 4 * fq;
#pragma unroll
        for (int ai = 0; ai < 2; ++ai)
#pragma unroll
            for (int mp = 0; mp < 2; ++mp) {
                f32x4 xv[2][2][2];
#pragma unroll
                for (int mm = 0; mm < 2; ++mm) { const float* xrow = xp + (size_t)(row0 + ai * 128 + (2 * mp + mm) * 16) * D + col0;
#pragma unroll
                    for (int bj = 0; bj < 2; ++bj)
#pragma unroll
                        for (int n = 0; n < 2; ++n) xv[mm][bj][n] = *(const f32x4*)(xrow + bj * 128 + n * 16); }
#pragma unroll
                for (int mm = 0; mm < 2; ++mm) { const int m = 2 * mp + mm; float ss = 0.f;
#pragma unroll
                    for (int bj = 0; bj < 2; ++bj)
#pragma unroll
                        for (int n = 0; n < 2; ++n) { const f32x4 v = xv[mm][bj][n] + acc[ai][bj][m][n]; acc[ai][bj][m][n] = v; ss += (v[0] * v[0] + v[1] * v[1]) + (v[2] * v[2] + v[3] * v[3]); }
                    ss += __shfl_xor(ss, 16); ss += __shfl_xor(ss, 32);
                    if (fq == 0) PT[(ai * 128 + wr * 64 + m * 16 + fr) * 4 + wc] = ss; }
                asm volatile("" ::: "memory"); }
        __syncthreads();
        if (tid < 256) { const f32x4 pt = *(const LAS f32x4*)(PT + tid * 4); const float t = (pt[0] + pt[1]) + (pt[2] + pt[3]);
            __hip_atomic_store(xbuf + ((size_t)u.pm * 256 + tid) * 4 + u.pn, t, __ATOMIC_RELAXED, __HIP_MEMORY_SCOPE_AGENT);
            asm volatile("s_waitcnt vmcnt(0)" ::: "memory");
            if (lane == 0) __hip_atomic_fetch_add(cnt + 64 * u.pm, 1u, __ATOMIC_RELAXED, __HIP_MEMORY_SCOPE_AGENT); }
        if (wid == 0) { unsigned sp = 0;
            while ((unsigned)__builtin_amdgcn_readfirstlane(__hip_atomic_load(cnt + 64 * u.pm, __ATOMIC_RELAXED, __HIP_MEMORY_SCOPE_AGENT)) < 16u) { __builtin_amdgcn_s_sleep(2); if (++sp > (1u << 22)) break; }
            __builtin_amdgcn_fence(__ATOMIC_ACQUIRE, "agent"); }
        asm volatile("s_waitcnt vmcnt(0)" ::: "memory");
        __syncthreads();
        if (tid < 256) { const float* sl = xbuf + ((size_t)u.pm * 256 + tid) * 4; float t = 0.f;
#pragma unroll
            for (int k = 0; k < 4; ++k) t += __hip_atomic_load(sl + k, __ATOMIC_RELAXED, __HIP_MEMORY_SCOPE_AGENT);
            ST[tid] = 1.f / sqrtf(t * (1.f / D) + EPS); }
        __syncthreads();
        f32x4 gg[2][2];
#pragma unroll
        for (int bj = 0; bj < 2; ++bj)
#pragma unroll
            for (int n = 0; n < 2; ++n) gg[bj][n] = *(const f32x4*)(fg + col0 + bj * 128 + n * 16);
#pragma unroll
        for (int ai = 0; ai < 2; ++ai)
#pragma unroll
            for (int m = 0; m < 4; ++m) { const int rl = ai * 128 + wr * 64 + m * 16 + fr; const float rs = ST[rl]; float* orow = out + (size_t)(u.pm * 256 + rl) * D + col0;
#pragma unroll
                for (int bj = 0; bj < 2; ++bj)
#pragma unroll
                    for (int n = 0; n < 2; ++n) __builtin_nontemporal_store(acc[ai][bj][m][n] * rs * gg[bj][n], (f32x4*)(orow + bj * 128 + n * 16)); }
        return false;
    }
};

__device__ __forceinline__ void attn_prompt_unit(LAS unsigned char* lds, bf16_t* P, const bf16_t* KB, const bf16_t* VtB, int unit, bool st = true) {
    const int tid = threadIdx.x, lane = tid & 63, wave = tid >> 6, r32 = lane & 31, hi = lane >> 5;
    const int b = unit >> 5, h = (unit >> 3) & 3, qb = unit & 7;
    LAS unsigned char* ldsK = lds; LAS unsigned char* ldsV = lds + 256 * 272;
    __syncthreads();
    for (int i = tid; i < 256 * 16; i += 512) { const int kv = i >> 4, c = i & 15; *(LAS u32x4*)(ldsK + kv * 272 + c * 16) = *(const u32x4*)(KB + (size_t)(b * 256 + kv) * XW + h * 128 + c * 8); }
    for (int i = tid; i < 128 * 32; i += 512) { const int d = i >> 5, c = i & 31; *(LAS u32x4*)(ldsV + d * 528 + c * 16) = *(const u32x4*)(VtB + ((size_t)(b * 4 + h) * 128 + d) * 256 + c * 8); }
    const size_t tok = (size_t)b * SEQ + qb * 256 + wave * 32;
    bf16x8 qf[8];
    { const bf16_t* qrow = P + (tok + r32) * PLD + PC_Q + h * 128 + 8 * hi;
#pragma unroll
        for (int s = 0; s < 8; ++s) qf[s] = *(const bf16x8*)(qrow + 16 * s); }
    __syncthreads();
    f32x16 sacc[8];
#pragma unroll
    for (int t = 0; t < 8; ++t) {
#pragma unroll
        for (int r = 0; r < 16; ++r) sacc[t][r] = 0.f;
#pragma unroll
        for (int s = 0; s < 8; ++s) { const bf16x8 kf = *(const LAS bf16x8*)(ldsK + (32 * t + r32) * 272 + (16 * s + 8 * hi) * 2); sacc[t] = __builtin_amdgcn_mfma_f32_32x32x16_bf16(kf, qf[s], sacc[t], 0, 0, 0); }
    }
    float mx = -3.0e38f;
#pragma unroll
    for (int t = 0; t < 8; ++t)
#pragma unroll
        for (int r = 0; r < 16; ++r) mx = fmaxf(mx, sacc[t][r]);
    mx = fmaxf(mx, __shfl_xor(mx, 32));
    float sum = 0.f;
#pragma unroll
    for (int t = 0; t < 8; ++t)
#pragma unroll
        for (int r = 0; r < 16; ++r) { const float e = __builtin_amdgcn_exp2f(sacc[t][r] - mx); sacc[t][r] = e; sum += e; }
    sum += __shfl_xor(sum, 32);
    const float inv = __builtin_amdgcn_rcpf(sum);
#pragma unroll
    for (int t = 0; t < 8; ++t)
#pragma unroll
        for (int r = 0; r < 16; ++r) sacc[t][r] *= inv;
#pragma unroll 1
    for (int dp = 0; dp < 2; ++dp) {
        f32x16 o[2];
#pragma unroll
        for (int dt = 0; dt < 2; ++dt)
#pragma unroll
            for (int r = 0; r < 16; ++r) o[dt][r] = 0.f;
        const LAS unsigned char* vbase = ldsV + (64 * dp + r32) * 528 + 16 * hi;
#pragma unroll
        for (int t = 0; t < 8; ++t) {
#pragma unroll
            for (int s2 = 0; s2 < 2; ++s2) {
                u32x4 pw; pw.x = cvt_pk_bf16(sacc[t][8 * s2 + 0], sacc[t][8 * s2 + 1]); pw.y = cvt_pk_bf16(sacc[t][8 * s2 + 2], sacc[t][8 * s2 + 3]);
                pw.z = cvt_pk_bf16(sacc[t][8 * s2 + 4], sacc[t][8 * s2 + 5]); pw.w = cvt_pk_bf16(sacc[t][8 * s2 + 6], sacc[t][8 * s2 + 7]);
                const bf16x8 pa = __builtin_bit_cast(bf16x8, pw);
#pragma unroll
                for (int dt = 0; dt < 2; ++dt) { const bf16x8 vf = *(const LAS bf16x8*)(vbase + dt * 32 * 528 + (32 * t + 16 * s2) * 2); o[dt] = __builtin_amdgcn_mfma_f32_32x32x16_bf16(vf, pa, o[dt], 0, 0, 0); }
            }
            __builtin_amdgcn_sched_barrier(0);
        }
        bf16_t* grow = P + (tok + r32) * PLD + PC_GC + h * 128 + 64 * dp + 8 * hi;
        __builtin_amdgcn_sched_barrier(0);
        u32x4 gw[2][2];
#pragma unroll
        for (int dt = 0; dt < 2; ++dt)
#pragma unroll
            for (int pr = 0; pr < 2; ++pr) gw[dt][pr] = *(const u32x4*)(grow + 32 * dt + 16 * pr);
#pragma unroll
        for (int dt = 0; dt < 2; ++dt)
#pragma unroll
            for (int pr = 0; pr < 2; ++pr) { float v[8], g[8]; unpack8(gw[dt][pr], g);
#pragma unroll
                for (int i = 0; i < 4; ++i) { const auto rr = __builtin_amdgcn_permlane32_swap(__float_as_uint(o[dt][8 * pr + i]), __float_as_uint(o[dt][8 * pr + 4 + i]), false, false);
                    v[i] = __uint_as_float(rr[0]); v[4 + i] = __uint_as_float(rr[1]); }
#pragma unroll
                for (int i = 0; i < 8; ++i) v[i] *= g[i];
                const u32x4 w = pack8(v); if (st) *(u32x4*)(grow + 32 * dt + 16 * pr) = w; else asm volatile("" :: "v"(w)); }
        __builtin_amdgcn_sched_barrier(0);
    }
}
__device__ __forceinline__ void attn_sample_unit(LAS unsigned char* lds, bf16_t* P, const float* ck, const float* cv, int unit, bool st = true) {
    const int tid = threadIdx.x, lane = tid & 63, wave = tid >> 6, l32 = lane & 31, half = lane >> 5;
    const int b = unit >> 2, h = unit & 3;
    LAS float* sc = (LAS float*)lds; LAS float* pn = sc + 256; LAS float* red = pn + 256;
    const bf16_t* qrow = P + (size_t)(MP + b) * PLD + PC_Q + h * 128;
    float q4[4]; { const u32x2 w = *(const u32x2*)(qrow + 4 * l32); q4[0] = bflo(w.x); q4[1] = bfhi(w.x); q4[2] = bflo(w.y); q4[3] = bfhi(w.y); }
    const float* kb = ck + ((size_t)b * 256 * 4 + h) * 128 + 4 * l32;
    const int d4 = tid & 31, mg = tid >> 5; const float* vb = cv + ((size_t)b * 256 * 4 + h) * 128 + 4 * d4;
    f32x4 k4[16], v4[16];
#pragma unroll
    for (int ps = 0; ps < 16; ++ps) k4[ps] = __builtin_nontemporal_load((const f32x4*)(kb + (size_t)(ps * 16 + wave * 2 + half) * 512));
#pragma unroll
    for (int i = 0; i < 16; ++i) v4[i] = __builtin_nontemporal_load((const f32x4*)(vb + (size_t)(mg * 16 + i) * 512));
    __syncthreads();
#pragma unroll
    for (int ps = 0; ps < 16; ++ps) { const int m = ps * 16 + wave * 2 + half;
        float s = (k4[ps][0] * q4[0] + k4[ps][1] * q4[1]) + (k4[ps][2] * q4[2] + k4[ps][3] * q4[3]);
        s += __shfl_xor(s, 1); s += __shfl_xor(s, 2); s += __shfl_xor(s, 4); s += __shfl_xor(s, 8); s += __shfl_xor(s, 16);
        if (l32 == 0) sc[m] = s; }
    __syncthreads();
    if (wave == 0) { float v[4]; float mx = -3.0e38f;
#pragma unroll
        for (int j = 0; j < 4; ++j) { v[j] = sc[lane + 64 * j]; mx = fmaxf(mx, v[j]); }
        mx = wave_max(mx); float sm = 0.f;
#pragma unroll
        for (int j = 0; j < 4; ++j) { v[j] = __builtin_amdgcn_exp2f(v[j] - mx); sm += v[j]; }
        sm = wave_sum(sm); const float inv = 1.f / sm;
#pragma unroll
        for (int j = 0; j < 4; ++j) pn[lane + 64 * j] = v[j] * inv; }
    __syncthreads();
    { f32x4 a = (f32x4){0.f, 0.f, 0.f, 0.f};
#pragma unroll
        for (int i = 0; i < 16; ++i) a += v4[i] * pn[mg * 16 + i];
        *(LAS f32x4*)(red + mg * 128 + 4 * d4) = a; }
    __syncthreads();
    if (tid < 128) { float o = 0.f;
#pragma unroll
        for (int g = 0; g < 16; ++g) o += red[g * 128 + tid];
        bf16_t* gp = P + (size_t)(MP + b) * PLD + PC_GC + h * 128 + tid; const float gv = bf2f(*gp); if (st) *gp = (bf16_t)(cvt_pk_bf16(o * gv, 0.f) & 0xffffu); }
}
__device__ __forceinline__ void attn_sample_phase(LAS unsigned char* lds, bf16_t* P, const float* ck, const float* cv, int u0, int nunits, int G) {
    const int tid = threadIdx.x, lane = tid & 63, wave = tid >> 6, l32 = lane & 31, half = lane >> 5;
    LAS float* sc = (LAS float*)lds; LAS float* pn = sc + 256; LAS float* red = pn + 256;
    const int d4 = tid & 31, mg = tid >> 5;
    if (u0 >= nunits) return;
    f32x4 k4[16], v4[16]; float q4[4];
#define AS_LOADK(uu) do { const int _b = (uu) >> 2, _h = (uu) & 3; const u32x2 _w = *(const u32x2*)(P + (size_t)(MP + _b) * PLD + PC_Q + _h * 128 + 4 * l32); \
        q4[0] = bflo(_w.x); q4[1] = bfhi(_w.x); q4[2] = bflo(_w.y); q4[3] = bfhi(_w.y); const float* _kb = ck + ((size_t)_b * 256 * 4 + _h) * 128 + 4 * l32; \
        _Pragma("unroll") for (int ps = 0; ps < 16; ++ps) k4[ps] = __builtin_nontemporal_load((const f32x4*)(_kb + (size_t)(ps * 16 + wave * 2 + half) * 512)); } while (0)
#define AS_LOADV(uu) do { const int _b = (uu) >> 2, _h = (uu) & 3; const float* _vb = cv + ((size_t)_b * 256 * 4 + _h) * 128 + 4 * d4; \
        _Pragma("unroll") for (int i = 0; i < 16; ++i) v4[i] = __builtin_nontemporal_load((const f32x4*)(_vb + (size_t)(mg * 16 + i) * 512)); } while (0)
    AS_LOADK(u0); AS_LOADV(u0);
    for (int u = u0; u < nunits; u += G) {
        const int b = u >> 2, h = u & 3; const bool hn = (u + G) < nunits;
        float sv[16];
#pragma unroll
        for (int ps = 0; ps < 16; ++ps) { float s = (k4[ps][0] * q4[0] + k4[ps][1] * q4[1]) + (k4[ps][2] * q4[2] + k4[ps][3] * q4[3]);
            s += __shfl_xor(s, 1); s += __shfl_xor(s, 2); s += __shfl_xor(s, 4); s += __shfl_xor(s, 8); s += __shfl_xor(s, 16); sv[ps] = s; }
        if (hn) AS_LOADK(u + G);
        __syncthreads();
#pragma unroll
        for (int ps = 0; ps < 16; ++ps) if (l32 == 0) sc[ps * 16 + wave * 2 + half] = sv[ps];
        __syncthreads();
        if (wave == 0) { float v[4]; float mx = -3.0e38f;
#pragma unroll
            for (int j = 0; j < 4; ++j) { v[j] = sc[lane + 64 * j]; mx = fmaxf(mx, v[j]); }
            mx = wave_max(mx); float sm = 0.f;
#pragma unroll
            for (int j = 0; j < 4; ++j) { v[j] = __builtin_amdgcn_exp2f(v[j] - mx); sm += v[j]; }
            sm = wave_sum(sm); const float inv = 1.f / sm;
#pragma unroll
            for (int j = 0; j < 4; ++j) pn[lane + 64 * j] = v[j] * inv; }
        __syncthreads();
        { f32x4 a = (f32x4){0.f, 0.f, 0.f, 0.f};
#pragma unroll
            for (int i = 0; i < 16; ++i) a += v4[i] * pn[mg * 16 + i];
            *(LAS f32x4*)(red + mg * 128 + 4 * d4) = a; }
        if (hn) AS_LOADV(u + G);
        __syncthreads();
        if (tid < 128) { float o = 0.f;
#pragma unroll
            for (int g = 0; g < 16; ++g) o += red[g * 128 + tid];
            bf16_t* gp = P + (size_t)(MP + b) * PLD + PC_GC + h * 128 + tid; const float gv = bf2f(*gp); *gp = (bf16_t)(cvt_pk_bf16(o * gv, 0.f) & 0xffffu); }
    }
#undef AS_LOADK
#undef AS_LOADV
}
constexpr int L_XA = 0, L_RAW0 = 17408, L_RAW1 = 34816, L_A = 52224, L_B = L_A + 33792, L_LRU_END = L_B + 33792;
static_assert(L_LRU_END <= 131072, "LRU LDS");
template <int MODE>
__device__ __forceinline__ void lru_phase(LAS unsigned char* lds, const Params& p, bf16_t* P, const bf16_t* WgT, float* agg, bf16_t* CG, int u0, int nunits, int G) {
    const int tid = threadIdx.x, lane = tid & 63, wave = tid >> 6;
    LAS float* LA = (LAS float*)(lds + L_A); LAS float* LB = (LAS float*)(lds + L_B);
    const float* cw = p.in[I_CW]; const float* cb = p.in[I_CB];
    const int ch8 = tid & 15, tl = tid >> 4, col = lane & 15, quad = lane >> 4;
    constexpr int NMT = (MODE == 2) ? 2 : 4, NRR = (MODE == 2) ? 1 : 2, UR = 16 * NMT;
    u32x4 pre[3];
    int buf = 0;
    __syncthreads();
    if (MODE != 2 && u0 < nunits) {
        const int n = u0 % 6, c = (u0 / 6) % NCH, b = u0 / (6 * NCH), t0 = c * TC;
#pragma unroll
        for (int k = 0; k < 3; ++k) { const int i = tid + 512 * k; const int r = i >> 4, c16 = i & 15, t = t0 - 3 + r; pre[k] = (u32x4){0u, 0u, 0u, 0u};
            if (i < 67 * 16 && t >= 0) pre[k] = *(const u32x4*)(P + ((size_t)b * SEQ + t) * PLD + PC_LX + n * 128 + 8 * c16); }
#pragma unroll
        for (int k = 0; k < 3; ++k) { const int i = tid + 512 * k; if (i < 67 * 16) *(LAS u32x4*)(lds + L_RAW0 + i * 16) = pre[k]; }
    }
    __syncthreads();
    for (int u = u0; u < nunits; u += G, buf ^= 1) {
        int b, c, n, t0; size_t tokbase;
        if (MODE == 2) { n = u % 6; c = u / 6; b = 0; t0 = 0; tokbase = (size_t)MP + UR * c; }
        else { n = u % 6; c = (u / 6) % NCH; b = u / (6 * NCH); t0 = c * TC; tokbase = (size_t)b * SEQ + t0; }
        const LAS bf16_t* RAW = (const LAS bf16_t*)(lds + (buf ? L_RAW1 : L_RAW0));
        const int chg8 = n * 128 + 8 * ch8;
        float w[4][8], bias[8];
#pragma unroll
        for (int k = 0; k < 4; ++k) { const f32x4 a = *(const f32x4*)(cw + k * LW + chg8), bb = *(const f32x4*)(cw + k * LW + chg8 + 4);
            w[k][0] = a[0]; w[k][1] = a[1]; w[k][2] = a[2]; w[k][3] = a[3]; w[k][4] = bb[0]; w[k][5] = bb[1]; w[k][6] = bb[2]; w[k][7] = bb[3]; }
        { const f32x4 a = *(const f32x4*)(cb + chg8), bb = *(const f32x4*)(cb + chg8 + 4); bias[0] = a[0]; bias[1] = a[1]; bias[2] = a[2]; bias[3] = a[3]; bias[4] = bb[0]; bias[5] = bb[1]; bias[6] = bb[2]; bias[7] = bb[3]; }
#pragma unroll
        for (int rr = 0; rr < NRR; ++rr) { const int tt = tl + 32 * rr; float xc[8];
#pragma unroll
            for (int j = 0; j < 8; ++j) xc[j] = bias[j];
            if (MODE != 2) {
#pragma unroll
                for (int k = 0; k < 4; ++k) { const u32x4 xw = *(const LAS u32x4*)(RAW + (tt + k) * 128 + 8 * ch8); float x[8]; unpack8(xw, x);
#pragma unroll
                    for (int j = 0; j < 8; ++j) xc[j] += w[k][j] * x[j];
                    if (k == 3 && c == NCH - 1 && tt >= 61) { float* o = p.out + O_PLC + ((size_t)b * 3 + (tt - 61)) * LW + chg8; *(f32x4*)o = (f32x4){x[0], x[1], x[2], x[3]}; *(f32x4*)(o + 4) = (f32x4){x[4], x[5], x[6], x[7]}; } }
            } else {
                const int smp = UR * c + tt; const float* sl = p.in[I_SLC] + (size_t)smp * 3 * LW + chg8; float* so = p.out + O_SLC + (size_t)smp * 3 * LW + chg8;
#pragma unroll
                for (int k = 0; k < 3; ++k) { const f32x4 a = *(const f32x4*)(sl + k * LW), bb = *(const f32x4*)(sl + k * LW + 4);
                    const float x[8] = {a[0], a[1], a[2], a[3], bb[0], bb[1], bb[2], bb[3]};
#pragma unroll
                    for (int j = 0; j < 8; ++j) xc[j] += w[k][j] * x[j];
                    if (k > 0) { *(f32x4*)(so + (k - 1) * LW) = a; *(f32x4*)(so + (k - 1) * LW + 4) = bb; } }
                float x[8]; unpack8(*(const u32x4*)(P + (tokbase + tt) * PLD + PC_LX + chg8), x);
#pragma unroll
                for (int j = 0; j < 8; ++j) xc[j] += w[3][j] * x[j];
                *(f32x4*)(so + 2 * LW) = (f32x4){x[0], x[1], x[2], x[3]}; *(f32x4*)(so + 2 * LW + 4) = (f32x4){x[4], x[5], x[6], x[7]};
            }
            *(LAS u32x4*)(lds + L_XA + tt * 272 + ch8 * 16) = pack8(xc); }
        const int d = 16 * wave + col, chg = n * 128 + d;
        const bf16_t* wrow = WgT + ((size_t)n * 256 + d) * 128 + 8 * quad;
        bf16x8 bwa[4], bwx[4];
#pragma unroll
        for (int ks = 0; ks < 4; ++ks) { bwa[ks] = *(const bf16x8*)(wrow + 32 * ks); bwx[ks] = *(const bf16x8*)(wrow + 128 * 128 + 32 * ks); }
        const float bav = p.in[I_BA][chg], bxv = p.in[I_BX][chg], cl = ((const float*)(p.ws + WS_WG + 524288))[chg];
        const float bav2 = -1.4426950408889634f * bav, bxv2 = -1.4426950408889634f * bxv, cl2 = 1.4426950408889634f * cl;
        __syncthreads();
        const int un = u + G; const bool hn = (MODE != 2) && (un < nunits);
        if (hn) { const int n2 = un % 6, c2 = (un / 6) % NCH, b2 = un / (6 * NCH), t02 = c2 * TC;
#pragma unroll
            for (int k = 0; k < 3; ++k) { const int i = tid + 512 * k; const int r = i >> 4, c16 = i & 15, t = t02 - 3 + r; pre[k] = (u32x4){0u, 0u, 0u, 0u};
                if (i < 67 * 16 && t >= 0) pre[k] = *(const u32x4*)(P + ((size_t)b2 * SEQ + t) * PLD + PC_LX + n2 * 128 + 8 * c16); } }
        u32x4 slw[NRR];
#pragma unroll
        for (int rr = 0; rr < NRR; ++rr) slw[rr] = *(const u32x4*)(P + (tokbase + tl + 32 * rr) * PLD + PC_GA + chg8);
        f32x4 aa[NMT], ax[NMT];
#pragma unroll
        for (int m = 0; m < NMT; ++m) { aa[m] = (f32x4){0.f, 0.f, 0.f, 0.f}; ax[m] = (f32x4){0.f, 0.f, 0.f, 0.f}; }
#pragma unroll
        for (int ks = 0; ks < 4; ++ks)
#pragma unroll
            for (int m = 0; m < NMT; ++m) { const bf16x8 af = *(const LAS bf16x8*)(lds + L_XA + (16 * m + col) * 272 + (32 * ks + 8 * quad) * 2);
                aa[m] = __builtin_amdgcn_mfma_f32_16x16x32_bf16(af, bwa[ks], aa[m], 0, 0, 0); ax[m] = __builtin_amdgcn_mfma_f32_16x16x32_bf16(af, bwx[ks], ax[m], 0, 0, 0); }
#pragma unroll
        for (int m = 0; m < NMT; ++m)
#pragma unroll
            for (int r = 0; r < 4; ++r) { const int t = 16 * m + 4 * quad + r;
                const float rg = __builtin_amdgcn_rcpf(1.f + __builtin_amdgcn_exp2f(__builtin_fmaf(aa[m][r], -1.4426950408889634f, bav2)));
                const float ig = __builtin_amdgcn_rcpf(1.f + __builtin_amdgcn_exp2f(__builtin_fmaf(ax[m][r], -1.4426950408889634f, bxv2)));
                const float a = __builtin_amdgcn_exp2f(cl2 * rg);
                const float em = __builtin_fmaf(-a, a, 1.0f);
                const float mult = __builtin_amdgcn_sqrtf(fmaxf(em, 0.f)); const float xcv = bf2f(*(const LAS bf16_t*)(lds + L_XA + t * 272 + d * 2));
                aa[m][r] = a; ax[m][r] = mult * ig * xcv; }
        if (MODE == 2) {
            const float* h0 = p.in[I_SH]; float* ho = p.out + O_SH;
#pragma unroll
            for (int m = 0; m < NMT; ++m)
#pragma unroll
                for (int r = 0; r < 4; ++r) { const int t = 16 * m + 4 * quad + r; const size_t idx = (size_t)(UR * c + t) * LW + chg; const float h = aa[m][r] * h0[idx] + ax[m][r]; ho[idx] = h; LB[t * 132 + d] = h; }
        } else {
            float cpc = 1.f, hc = 0.f;
#pragma unroll
            for (int m = 0; m < NMT; ++m) {
                float A = 1.f, H = 0.f;
#pragma unroll
                for (int r = 0; r < 4; ++r) { H = aa[m][r] * H + ax[m][r]; A *= aa[m][r]; }
                float Ai = A, Hi = H;
                { const float Ap = __shfl_up(Ai, 16), Hp = __shfl_up(Hi, 16); if (quad >= 1) { Hi = Ai * Hp + Hi; Ai = Ai * Ap; } }
                { const float Ap = __shfl_up(Ai, 32), Hp = __shfl_up(Hi, 32); if (quad >= 2) { Hi = Ai * Hp + Hi; Ai = Ai * Ap; } }
                float Ae = __shfl_up(Ai, 16), He = __shfl_up(Hi, 16); if (quad == 0) { Ae = 1.f; He = 0.f; }
                const float At = __shfl(Ai, 48 + col), Ht = __shfl(Hi, 48 + col);
                float cp = Ae * cpc, h = Ae * hc + He;
#pragma unroll
                for (int r = 0; r < 4; ++r) { const int t = 16 * m + 4 * quad + r; h = aa[m][r] * h + ax[m][r]; cp *= aa[m][r]; LB[t * 132 + d] = h; LA[t * 132 + d] = cp; }
                hc = At * hc + Ht; cpc = At * cpc;
            }
            if (quad == 0) { float* ag = agg + (((size_t)b * NCH + c) * LW + chg) * 2; *(float2*)ag = make_float2(cpc, hc); }
        }
        if (hn) {
#pragma unroll
            for (int k = 0; k < 3; ++k) { const int i = tid + 512 * k; if (i < 67 * 16) *(LAS u32x4*)(lds + (buf ? L_RAW0 : L_RAW1) + i * 16) = pre[k]; } }
        __syncthreads();
#pragma unroll
        for (int rr = 0; rr < NRR; ++rr) { const int tt = tl + 32 * rr; bf16_t* gp = P + (tokbase + tt) * PLD + PC_GA + chg8;
            float g[8]; unpack8(slw[rr], g); const f32x4 h0 = *(const LAS f32x4*)(LB + tt * 132 + 8 * ch8), h1 = *(const LAS f32x4*)(LB + tt * 132 + 8 * ch8 + 4);
            if (MODE == 0) { const f32x4 c0 = *(const LAS f32x4*)(LA + tt * 132 + 8 * ch8), c1 = *(const LAS f32x4*)(LA + tt * 132 + 8 * ch8 + 4);
                float cgv[8] = {g[0] * c0[0], g[1] * c0[1], g[2] * c0[2], g[3] * c0[3], g[4] * c1[0], g[5] * c1[1], g[6] * c1[2], g[7] * c1[3]};
                *(u32x4*)(CG + (tokbase + tt) * LW + chg8) = pack8(cgv); }
            g[0] *= h0[0]; g[1] *= h0[1]; g[2] *= h0[2]; g[3] *= h0[3]; g[4] *= h1[0]; g[5] *= h1[1]; g[6] *= h1[2]; g[7] *= h1[3];
            *(u32x4*)gp = pack8(g); }
    }
}
__device__ __forceinline__ void lru_fix_item(LAS unsigned char* lds, const Params& p, bf16_t* P, const bf16_t* CG, const float* agg, int item) {
    const int tid = threadIdx.x; const int b = item >> 5, cq = (item >> 2) & 7, ns = item & 3;
    LAS float* HIN = (LAS float*)lds;
    __syncthreads();
    if (tid < 192) { const int ch = 192 * ns + tid; const float* ag = agg + ((size_t)b * NCH * LW + ch) * 2; float h = 0.f;
        const int cend = (cq == 7) ? NCH : 4 * cq + 4;
        for (int c0 = 0; c0 < cend; c0 += 8) { float A8[8], H8[8];
#pragma unroll
            for (int j = 0; j < 8; ++j) { A8[j] = 1.f; H8[j] = 0.f; if (c0 + j < cend) { const float2 v = *(const float2*)(ag + (size_t)(c0 + j) * LW * 2); A8[j] = v.x; H8[j] = v.y; } }
#pragma unroll
            for (int j = 0; j < 8; ++j) { const int cc = c0 + j; if (cc >= 4 * cq && cc < 4 * cq + 4) HIN[(cc - 4 * cq) * 192 + tid] = h; h = A8[j] * h + H8[j]; } }
        if (cq == 7) p.out[O_PH + (size_t)b * LW + ch] = h; }
    __syncthreads();
    if (tid < 504) { const int ch8 = tid % 24, rg = tid / 24; const int chb = 192 * ns + 8 * ch8;
#pragma unroll 1
        for (int cc = (cq == 0 ? 1 : 0); cc < 4; ++cc) {
            const f32x4 ha = *(const LAS f32x4*)(HIN + cc * 192 + 8 * ch8), hb = *(const LAS f32x4*)(HIN + cc * 192 + 8 * ch8 + 4);
            const size_t tok0 = (size_t)b * SEQ + (4 * cq + cc) * TC;
            u32x4 gw_[4], cw_[4];
#pragma unroll
            for (int k = 0; k < 4; ++k) { const int r = rg + 21 * k; if (r < 64) { gw_[k] = __builtin_nontemporal_load((const u32x4*)(P + (tok0 + r) * PLD + PC_GA + chb)); cw_[k] = __builtin_nontemporal_load((const u32x4*)(CG + (tok0 + r) * LW + chb)); } }
#pragma unroll
            for (int k = 0; k < 4; ++k) { const int r = rg + 21 * k; if (r < 64) { float g[8], cgv[8]; unpack8(gw_[k], g); unpack8(cw_[k], cgv);
                g[0] += cgv[0] * ha[0]; g[1] += cgv[1] * ha[1]; g[2] += cgv[2] * ha[2]; g[3] += cgv[3] * ha[3]; g[4] += cgv[4] * hb[0]; g[5] += cgv[5] * hb[1]; g[6] += cgv[6] * hb[2]; g[7] += cgv[7] * hb[3];
                *(u32x4*)(P + (tok0 + r) * PLD + PC_GA + chb) = pack8(g); } }
        }
    }
}
__device__ __forceinline__ void sconv_prompt_unit(const Params& p, bf16_t* P, int unit, bool st = true) {
    const int tid = threadIdx.x; if (tid >= 384) return;
    const int ch8 = tid % 96, tg = tid / 96; const int tokg = unit * 64 + tg * 16; const int b = tokg >> 11, t0 = tokg & (SEQ - 1);
    const float* sw = p.in[I_SCW] + 8 * ch8; float w[3][8];
#pragma unroll
    for (int k = 0; k < 3; ++k) { const f32x4 a = *(const f32x4*)(sw + k * LW), bb = *(const f32x4*)(sw + k * LW + 4); w[k][0] = a[0]; w[k][1] = a[1]; w[k][2] = a[2]; w[k][3] = a[3]; w[k][4] = bb[0]; w[k][5] = bb[1]; w[k][6] = bb[2]; w[k][7] = bb[3]; }
    float c2[8], c1[8];
#pragma unroll
    for (int j = 0; j < 8; ++j) { c2[j] = 0.f; c1[j] = 0.f; }
    if (t0 >= 2) { unpack8(*(const u32x4*)(P + (size_t)(tokg - 2) * PLD + PC_CIN + 8 * ch8), c2); unpack8(*(const u32x4*)(P + (size_t)(tokg - 1) * PLD + PC_CIN + 8 * ch8), c1); }
#pragma unroll 1
    for (int i0 = 0; i0 < 16; i0 += 8) {
        u32x4 cw_[8], gw_[8];
#pragma unroll
        for (int i = 0; i < 8; ++i) { const bf16_t* prow = P + (size_t)(tokg + i0 + i) * PLD; cw_[i] = *(const u32x4*)(prow + PC_CIN + 8 * ch8); gw_[i] = *(const u32x4*)(prow + PC_GB + 8 * ch8); }
#pragma unroll
        for (int i = 0; i < 8; ++i) { bf16_t* prow = P + (size_t)(tokg + i0 + i) * PLD; float c0[8], g[8]; unpack8(cw_[i], c0); unpack8(gw_[i], g);
#pragma unroll
            for (int j = 0; j < 8; ++j) g[j] *= (w[0][j] * c2[j] + w[1][j] * c1[j] + w[2][j] * c0[j]);
            if (st) *(u32x4*)(prow + PC_GB + 8 * ch8) = pack8(g);
            if (t0 + i0 + i >= SEQ - 2) { float* o = p.out + O_PSC + ((size_t)b * 2 + (t0 + i0 + i - (SEQ - 2))) * LW + 8 * ch8; *(f32x4*)o = (f32x4){c0[0], c0[1], c0[2], c0[3]}; *(f32x4*)(o + 4) = (f32x4){c0[4], c0[5], c0[6], c0[7]}; }
#pragma unroll
            for (int j = 0; j < 8; ++j) { c2[j] = c1[j]; c1[j] = c0[j]; } }
    }
}
__device__ __forceinline__ void sconv_fix(const Params& p, bf16_t* P, int bx, int G) {
    const int tid = threadIdx.x;
    const int bxs = (G >= 192) ? bx - 96 : bx;
    if (bxs < 0) return;
    for (int i = bxs * 512 + tid; i < 64 * 4 * 2 * 96; i += G * 512) { const int ch8 = i % 96, ri = i / 96; const int j = ri & 1, g = (ri >> 1) & 3, pm = ri >> 3;
        const int row = 256 * pm + 64 * g + j, t = row & (SEQ - 1);
        const float* sw = p.in[I_SCW] + 8 * ch8; bf16_t* prow = P + (size_t)row * PLD;
        float c0[8], c1[8], c2[8], gv[8];
        unpack8(*(const u32x4*)(prow + PC_CIN + 8 * ch8), c0); unpack8(*(const u32x4*)(prow + PC_GB + 8 * ch8), gv);
#pragma unroll
        for (int k = 0; k < 8; ++k) { c1[k] = 0.f; c2[k] = 0.f; }
        if (t >= 1) unpack8(*(const u32x4*)(prow - PLD + PC_CIN + 8 * ch8), c1);
        if (t >= 2) unpack8(*(const u32x4*)(prow - 2 * PLD + PC_CIN + 8 * ch8), c2);
#pragma unroll
        for (int hh = 0; hh < 2; ++hh) { const f32x4 w0 = *(const f32x4*)(sw + 4 * hh), w1 = *(const f32x4*)(sw + LW + 4 * hh), w2 = *(const f32x4*)(sw + 2 * LW + 4 * hh);
#pragma unroll
            for (int k = 0; k < 4; ++k) gv[4 * hh + k] *= (w0[k] * c2[4 * hh + k] + w1[k] * c1[4 * hh + k] + w2[k] * c0[4 * hh + k]); }
        *(u32x4*)(prow + PC_GB + 8 * ch8) = pack8(gv); }
    for (int i = bxs * 512 + tid; i < NB * 2 * 96; i += G * 512) { const int ch8 = i % 96, ri = i / 96; const int k = ri & 1, b = ri >> 1;
        float c0[8]; unpack8(*(const u32x4*)(P + ((size_t)b * SEQ + SEQ - 2 + k) * PLD + PC_CIN + 8 * ch8), c0);
        float* o = p.out + O_PSC + ((size_t)b * 2 + k) * LW + 8 * ch8; *(f32x4*)o = (f32x4){c0[0], c0[1], c0[2], c0[3]}; *(f32x4*)(o + 4) = (f32x4){c0[4], c0[5], c0[6], c0[7]}; }
}
__device__ __forceinline__ void sconv_sample_unit(const Params& p, bf16_t* P, int unit) {
    for (int idx = threadIdx.x; idx < 32 * 96; idx += 512) { const int smp = unit * 32 + idx / 96, ch8 = idx % 96;
        const float* sw = p.in[I_SCW] + 8 * ch8; const float* st = p.in[I_SSC] + (size_t)smp * 2 * LW + 8 * ch8; float* so = p.out + O_SSC + (size_t)smp * 2 * LW + 8 * ch8;
        bf16_t* prow = P + (size_t)(MP + smp) * PLD; float c0[8], g[8]; unpack8(*(const u32x4*)(prow + PC_CIN + 8 * ch8), c0); unpack8(*(const u32x4*)(prow + PC_GB + 8 * ch8), g);
#pragma unroll
        for (int hh = 0; hh < 2; ++hh) { const f32x4 b0 = *(const f32x4*)(st + 4 * hh), b1 = *(const f32x4*)(st + LW + 4 * hh), w0 = *(const f32x4*)(sw + 4 * hh), w1 = *(const f32x4*)(sw + LW + 4 * hh), w2 = *(const f32x4*)(sw + 2 * LW + 4 * hh);
#pragma unroll
            for (int j = 0; j < 4; ++j) g[4 * hh + j] *= (w0[j] * b0[j] + w1[j] * b1[j] + w2[j] * c0[4 * hh + j]);
            *(f32x4*)(so + 4 * hh) = b1; *(f32x4*)(so + LW + 4 * hh) = (f32x4){c0[4 * hh], c0[4 * hh + 1], c0[4 * hh + 2], c0[4 * hh + 3]}; }
        *(u32x4*)(prow + PC_GB + 8 * ch8) = pack8(g); }
}

__device__ __forceinline__ void sample_g2(LAS unsigned char* lds, bf16_t* P, const bf16_t* WcatT, int bx, int G) {
    const int tid = threadIdx.x, lane = tid & 63, wave = tid >> 6, ti = wave >> 2, role = wave & 3, col = lane & 15, quad = lane >> 4;
    LAS float* red = (LAS float*)lds;
    for (int base = 2 * bx; base < 512; base += 2 * G) {
        const int id = base + ti, mt = id & 7, nt16 = id >> 3;
        __syncthreads();
        if (role < 3) {
            const int koff = 768 * role, nks = role < 2 ? 24 : 16;
            const bf16_t* ap = P + (size_t)(MP + 16 * mt + col) * PLD + koff + 8 * quad;
            const bf16_t* bp = WcatT + (size_t)(16 * nt16 + col) * 2048 + koff + 8 * quad;
            f32x4 acc = (f32x4){0.f, 0.f, 0.f, 0.f};
#pragma unroll 8
            for (int ks = 0; ks < nks; ++ks) { const bf16x8 a = *(const bf16x8*)(ap + 32 * ks), b = *(const bf16x8*)(bp + 32 * ks); acc = __builtin_amdgcn_mfma_f32_16x16x32_bf16(a, b, acc, 0, 0, 0); }
#pragma unroll
            for (int r = 0; r < 4; ++r) acc[r] *= bf2f(P[(size_t)(MP + 16 * mt + 4 * quad + r) * PLD + PC_G + 1024 * role + 16 * nt16 + col]);
            *(LAS f32x4*)(red + ((ti * 3 + role) * 64 + lane) * 4) = acc;
        }
        __syncthreads();
        if (role == 0) {
            const f32x4 v = *(const LAS f32x4*)(red + ((ti * 3 + 0) * 64 + lane) * 4) + *(const LAS f32x4*)(red + ((ti * 3 + 1) * 64 + lane) * 4) + *(const LAS f32x4*)(red + ((ti * 3 + 2) * 64 + lane) * 4);
#pragma unroll
            for (int r = 0; r < 4; ++r) P[(size_t)(MP + 16 * mt + 4 * quad + r) * PLD + PC_MRG + 16 * nt16 + col] = (bf16_t)(cvt_pk_bf16(v[r], 0.f) & 0xffffu);
        }
    }
}
__device__ __forceinline__ void sample_g3(LAS unsigned char* lds, const bf16_t* P, const bf16_t* WoutT, const float* xs, float* out, float* rss2, int bx, int G) {
    const int tid = threadIdx.x, lane = tid & 63, wave = tid >> 6, ti = wave >> 2, role = wave & 3, col = lane & 15, quad = lane >> 4;
    LAS float* red = (LAS float*)lds;
    for (int base = 2 * bx; base < 512; base += 2 * G) {
        const int id = base + ti, mt = id & 7, nt16 = id >> 3;
        __syncthreads();
        {
            const bf16_t* ap = P + (size_t)(MP + 16 * mt + col) * PLD + PC_MRG + 256 * role + 8 * quad;
            const bf16_t* bp = WoutT + (size_t)(16 * nt16 + col) * D + 256 * role + 8 * quad;
            f32x4 acc = (f32x4){0.f, 0.f, 0.f, 0.f};
#pragma unroll
            for (int ks = 0; ks < 8; ++ks) { const bf16x8 a = *(const bf16x8*)(ap + 32 * ks), b = *(const bf16x8*)(bp + 32 * ks); acc = __builtin_amdgcn_mfma_f32_16x16x32_bf16(a, b, acc, 0, 0, 0); }
            *(LAS f32x4*)(red + ((ti * 4 + role) * 64 + lane) * 4) = acc;
        }
        __syncthreads();
        if (role == 0) {
            const f32x4 v = (*(const LAS f32x4*)(red + ((ti * 4 + 0) * 64 + lane) * 4) + *(const LAS f32x4*)(red + ((ti * 4 + 1) * 64 + lane) * 4)) + (*(const LAS f32x4*)(red + ((ti * 4 + 2) * 64 + lane) * 4) + *(const LAS f32x4*)(red + ((ti * 4 + 3) * 64 + lane) * 4));
#pragma unroll
            for (int r = 0; r < 4; ++r) { const int m = 16 * mt + 4 * quad + r, n = 16 * nt16 + col; const float xo = xs[(size_t)m * D + n] + v[r]; out[(size_t)(MP + m) * D + n] = xo;
                float ss = xo * xo; ss += __shfl_xor(ss, 1); ss += __shfl_xor(ss, 2); ss += __shfl_xor(ss, 4); ss += __shfl_xor(ss, 8);
                if (col == 0) rss2[m * 64 + nt16] = ss; }
        }
    }
}

__global__ void __launch_bounds__(512, 2) fwd_kernel(Params p) {
    extern __shared__ __attribute__((aligned(16))) unsigned char lds_raw[];
    LAS unsigned char* lds = (LAS unsigned char*)lds_raw;
    volatile LAS unsigned* MISC = (volatile LAS unsigned*)(lds + 131072 + 8192);
    const int tid = threadIdx.x, G = gridDim.x, bx = blockIdx.x;
    const int vcu = (G % 8 == 0) ? (bx % 8) * (G / 8) + bx / 8 : bx;
    if (tid < 64) MISC[tid] = 0u;
    __syncthreads();
    const int lo = p.ph_lo, hi = p.ph_hi;
    const bool multi = (hi - lo) > 1;
    XcdBarrier bar; bar.bar = (unsigned*)(p.ws + WS_CTL); bar.x = 0; bar.st = nullptr;
    if (multi) bar = xcd_barrier_post((unsigned*)(p.ws + WS_CTL), MISC + 8);
#ifndef PHASE_MASK
#define PHASE_MASK 0x7f
#endif
#ifndef UNIT_MASK
#define UNIT_MASK 0x3f
#endif
#define IN(k) ((((PHASE_MASK) >> (k)) & 1) && lo <= (k) && (k) < hi)
#define SEAM(k) do { if (IN(k) && IN((k) + 1)) xcd_barrier(bar); } while (0)
    bf16_t* P = (bf16_t*)(p.ws + WS_P);
    bf16_t* U = (bf16_t*)((unsigned char*)p.out + DO_U); bf16_t* WinT = (bf16_t*)((unsigned char*)p.out + DO_WIN);
    bf16_t* WcatT = (bf16_t*)(p.ws + WS_WCAT); bf16_t* WoutT = (bf16_t*)(p.ws + WS_WOUT); bf16_t* WgT = (bf16_t*)(p.ws + WS_WG);
    bf16_t* KB = (bf16_t*)(p.ws + WS_KB); bf16_t* VtB = (bf16_t*)(p.ws + WS_VT); float* agg = (float*)(p.ws + WS_AGG); bf16_t* CG = (bf16_t*)((unsigned char*)p.out + DO_U); float* rss = (float*)(p.ws + WS_RSS); float* rss2 = rss + (size_t)MPAD * 16;

#ifndef DUP_MASK
#define DUP_MASK 0
#endif
    const int nfull = (65 * 34 + 32) % G;
    const bool defer = (nfull != 0) && (G - nfull >= 32);
    if (IN(0)) { p0_prologue(p, lds, vcu * 8 + (tid >> 6), G * 8, 0); if (!defer) p0_prologue(p, lds, vcu * 8 + (tid >> 6), G * 8, 1); }
    SEAM(0);
    if (IN(1)) {
        pg8::Gemm g{U, WinT, D, D}; Sched1 S{G, bx}; Epi1 E{P, p.out + O_PMK, p.out + O_PMV, KB, VtB, p.in[I_SCW]};
        pg8::gemm_phase<Epi1, Sched1>(lds, g, S, E);
        if (defer && bx >= nfull) p0_prologue(p, lds, (bx - nfull) * 8 + (tid >> 6), (G - nfull) * 8, 1);
    }
    SEAM(1);
    if (IN(2)) {
        const bool nost = (p.ph_lo != 0);
        if (DUP_MASK & 0x100) for (int u = bx; u < 256; u += G) attn_prompt_unit(lds, P, KB, VtB, u, nost);
        if (DUP_MASK & 0x200) for (int u = bx; u < 512; u += G) attn_sample_unit(lds, P, p.in[I_CK], p.in[I_CV], u, nost);
        if (DUP_MASK & 0x800) for (int u = bx; u < 256; u += G) sconv_prompt_unit(p, P, u, nost);
        if (UNIT_MASK & 1) for (int u = bx; u < 256; u += G) attn_prompt_unit(lds, P, KB, VtB, u);
        if (UNIT_MASK & 2) attn_sample_phase(lds, P, p.in[I_CK], p.in[I_CV], bx, 512, G);
        if (UNIT_MASK & 4) lru_phase<0>(lds, p, P, WgT, agg, CG, bx, NB * NCH * NLB, G);
        if (UNIT_MASK & 8) lru_phase<2>(lds, p, P, WgT, agg, CG, G - 1 - bx, 24, G);
        if (UNIT_MASK & 16) sconv_fix(p, P, bx, G);
        if (UNIT_MASK & 32) for (int u = bx - 32; u >= 0 && u < 4; u += G) sconv_sample_unit(p, P, u);
    }
    SEAM(2);
    if (IN(3)) {
        sample_g2(lds, P, WcatT, bx, G);
        for (int u = vcu; u < 256; u += G) lru_fix_item(lds, p, P, CG, agg, u);
    }
    SEAM(3);
    if (IN(4)) {
        { pg8::Gemm g{P, WcatT, PLD, 2048}; Sched2 S{G, vcu, 0, 256}; Epi2 E{P}; pg8::gemm_phase<Epi2, Sched2>(lds, g, S, E); if (DUP_MASK & 16) pg8::gemm_phase<Epi2, Sched2>(lds, g, S, E); }
        sample_g3(lds, P, WoutT, p.in[I_XS], p.out, rss2, bx, G);
    }
    SEAM(4);
    const bool fused_norm = (G == 256);
    if (IN(5)) {
        pg8::Gemm g{P, WoutT, PLD, D}; Sched3 S{G, vcu, 0, 256};
        if (fused_norm) { Epi3F E{p.in[I_XP], p.out, p.in[I_FNG], (float*)(p.ws + WS_CTL + 65536), (unsigned*)(p.ws + WS_CTL) + 4096, lds}; pg8::gemm_phase<Epi3F, Sched3>(lds, g, S, E); }
        else { Epi3 E{p.in[I_XP], p.in[I_XS], p.out, rss}; pg8::gemm_phase<Epi3, Sched3>(lds, g, S, E); }
    }
    if (!fused_norm) SEAM(5);
    if (IN(6)) {
        const int lane = tid & 63, wave = tid >> 6; const float* fg = p.in[I_FNG];
        for (int m = (fused_norm ? MP : 0) + vcu * 8 + wave; m < MT; m += G * 8) {
            float ss;
            if (m < MP) { const f32x4* rs = (const f32x4*)(rss + (size_t)m * 16); const f32x4 a = rs[0], b2 = rs[1], c2 = rs[2], d2 = rs[3];
                ss = ((a[0] + a[1]) + (a[2] + a[3])) + ((b2[0] + b2[1]) + (b2[2] + b2[3])) + ((c2[0] + c2[1]) + (c2[2] + c2[3])) + ((d2[0] + d2[1]) + (d2[2] + d2[3])); }
            else ss = wave_sum(rss2[(m - MP) * 64 + lane]);
            const float rstd = 1.f / sqrtf(ss * (1.f / D) + EPS);
            f32x4* row = (f32x4*)(p.out + (size_t)m * D) + lane; const f32x4* gr = (const f32x4*)fg + lane;
#pragma unroll
            for (int j = 0; j < 4; ++j) { const f32x4 v = row[64 * j], gg = gr[64 * j]; row[64 * j] = v * rstd * gg; }
        }
    }
#undef IN
#undef SEAM
}

#ifndef MK_N_LAUNCHES
#define MK_N_LAUNCHES 1
#endif
extern "C" void kernel_launch(void* const* d_in, const int* in_sizes, int n_in, void* d_out, int out_size, void* d_ws, size_t ws_size, hipStream_t stream) {
    static int grid = 0;
    if (grid == 0) {
        if (n_in != 26 || out_size != (int)O_END || ws_size < WS_END) { fprintf(stderr, "kernel_launch: unexpected shapes (n_in %d, out %d, ws %zu)\n", n_in, out_size, ws_size); grid = -1; return; }
        int dev = 0, cus = 0, per_cu = 0;
        hipGetDevice(&dev); hipDeviceGetAttribute(&cus, hipDeviceAttributeMultiprocessorCount, dev);
        if (hipFuncSetAttribute((const void*)fwd_kernel, hipFuncAttributeMaxDynamicSharedMemorySize, LDS_BYTES) != hipSuccess) { fprintf(stderr, "kernel_launch: hipFuncSetAttribute failed\n"); grid = -1; return; }
        hipOccupancyMaxActiveBlocksPerMultiprocessor(&per_cu, (const void*)fwd_kernel, 512, LDS_BYTES);
        (void)hipGetLastError();
        if (per_cu < 1) fprintf(stderr, "kernel_launch: occupancy query says %d blocks per CU\n", per_cu);
        grid = cus;
    }
    if (grid < 0) return;
    (void)hipMemsetAsync((char*)d_ws + WS_CTL, 0, 32768, stream);
    Params p{};
    for (int i = 0; i < 26; ++i) p.in[i] = (const float*)d_in[i];
    p.out = (float*)d_out; p.ws = (unsigned char*)d_ws;
#if MK_N_LAUNCHES == 1
    p.ph_lo = 0; p.ph_hi = 7;
    void* args[] = {&p};
    hipError_t e = hipLaunchCooperativeKernel((const void*)fwd_kernel, dim3(grid), dim3(512), args, LDS_BYTES, stream);
    if (e != hipSuccess) fprintf(stderr, "cooperative launch failed: %s (grid %d)\n", hipGetErrorString(e), grid);
#else
    for (int k = 0; k < 7; ++k) { p.ph_lo = k; p.ph_hi = k + 1; hipLaunchKernelGGL(fwd_kernel, dim3(grid), dim3(512), LDS_BYTES, stream, p); }
#endif
}
```
